# Optimizing an MI355X kernel written in HIP

```python
import math
import jax, jax.numpy as jnp
from jax import lax
import numpy as np

D_MODEL = 1024
BATCH = 8
SEQ = 2048
DEPTH = 1
DEC_BATCH = 8
DEC_SEQ = 64
PAST_LEN = 2048

CHUNK = 64
A_HEADS = 4
A_DK = 128
A_DV = 128
A_WIDTH = A_HEADS * A_DV
B_HEADS = 8
B_KV_HEADS = 4
B_HD = 64
B_WIDTH = B_HEADS * B_HD
IDX_HEADS = 8
IDX_DIM = 64
TOPK_MAX = 256
QBLOCK = 128
ROT_FRAC = 4
ROPE_THETA = 500000.0
MIX_WIDTH = A_WIDTH + B_WIDTH
D_FF = 4 * D_MODEL
EPS = 1e-6
IN_SIZES = (A_HEADS * A_DK, A_HEADS * A_DK, A_WIDTH, A_WIDTH,
            B_HEADS * B_HD, B_KV_HEADS * B_HD, B_KV_HEADS * B_HD,
            IDX_HEADS * IDX_DIM, IDX_DIM, IDX_HEADS)
IN_WIDTH = sum(IN_SIZES)

kernel_name = "hymba_hgrn2_dsa_streaming_step"


def rmsnorm(x, g):
    xf = x.astype(jnp.float32)
    y = xf * lax.rsqrt(jnp.mean(jnp.square(xf), axis=-1, keepdims=True) + EPS)
    return (y * g.astype(jnp.float32)).astype(x.dtype)


def split_cols(z):
    pts, acc = [], 0
    for s in IN_SIZES[:-1]:
        acc += s
        pts.append(acc)
    return jnp.split(z, pts, axis=-1)


def partial_rope(x, pos):
    rot = x.shape[-1] // ROT_FRAC
    half = rot // 2
    inv = jnp.power(ROPE_THETA, -jnp.arange(half, dtype=jnp.float32) * (2.0 / rot))
    ang = pos.astype(jnp.float32)[:, None] * inv[None, :]
    cos = jnp.cos(ang)[None, :, None, :]
    sin = jnp.sin(ang)[None, :, None, :]
    xr = x[..., :rot].astype(jnp.float32)
    x1, x2 = xr[..., :half], xr[..., half:]
    out = jnp.concatenate([x1 * cos - x2 * sin, x2 * cos + x1 * sin], axis=-1).astype(x.dtype)
    return jnp.concatenate([out, x[..., rot:]], axis=-1)


def hgrn2_mix(q_pre, f_pre, v, gate_pre, lb, s0, g_norm):
    bsz, T = q_pre.shape[:2]
    C = min(CHUNK, T)
    N = T // C
    q = jax.nn.silu(q_pre.astype(jnp.float32))
    f = lb + (1.0 - lb) * jax.nn.sigmoid(f_pre.astype(jnp.float32))
    logf = jnp.log(f)
    k = 1.0 - f
    vf = v.astype(jnp.float32)

    def to_chunks(a):
        return jnp.moveaxis(a.reshape(bsz, N, C, *a.shape[2:]), 1, 0)

    mask = jnp.tril(jnp.ones((C, C), dtype=bool))[None, :, :, None, None]

    def step(S, inp):
        qc, kc, vc, lc = inp
        b = jnp.cumsum(lc, axis=1)
        diff = b[:, :, None] - b[:, None, :]
        decay = jnp.exp(jnp.where(mask, diff, -jnp.inf))
        attn = jnp.einsum('bthk,bshk,btshk->bhts', qc, kc, decay)
        o = (jnp.einsum('bhts,bshv->bthv', attn, vc)
             + jnp.einsum('bthk,bhkv->bthv', qc * jnp.exp(b), S))
        bl = b[:, -1]
        kd = kc * jnp.exp(bl[:, None] - b)
        S_new = jnp.exp(bl)[..., None] * S + jnp.einsum('bshk,bshv->bhkv', kd, vc)
        return S_new, o

    S, o = lax.scan(step, s0.astype(jnp.float32),
                    (to_chunks(q), to_chunks(k), to_chunks(vf), to_chunks(logf)))
    o = jnp.moveaxis(o, 0, 1).reshape(bsz, T, A_HEADS, A_DV)
    o = rmsnorm(o, g_norm.reshape(A_HEADS, A_DV)) * jax.nn.silu(gate_pre.astype(jnp.float32))
    return o.reshape(bsz, T, A_WIDTH), S


def dsa_attend(q, k_all, v_all, qi, ki_all, wi, q_pos):
    bsz, Tq = q.shape[:2]
    Tk = k_all.shape[1]
    topk = min(TOPK_MAX, Tk // 4)
    qb = min(QBLOCK, Tq)
    nb = Tq // qb
    G = B_HEADS // B_KV_HEADS
    scale = B_HD ** -0.5
    key_chunk = jnp.arange(Tk) // CHUNK
    ki32 = ki_all.astype(jnp.float32)

    def blocks(a):
        return jnp.moveaxis(a.reshape(bsz, nb, qb, *a.shape[2:]), 1, 0)

    def block(args):
        qc, qic, wic, qp = args
        qchunk = qp // CHUNK
        s_idx = jnp.einsum('bqhd,bkd->bqhk', qic.astype(jnp.float32), ki32)
        score = jnp.einsum('bqh,bqhk->bqk', wic.astype(jnp.float32), jax.nn.relu(s_idx))
        visible = key_chunk[None, :] <= qchunk[:, None]
        score = jnp.where(visible[None], score, -jnp.inf)
        _, sel = lax.top_k(score, topk)
        valid = (sel // CHUNK) <= qchunk[None, :, None]
        kg = jax.vmap(lambda kk, ss: kk[ss])(k_all, sel)
        vg = jax.vmap(lambda vv, ss: vv[ss])(v_all, sel)
        qg = qc.reshape(bsz, qb, B_KV_HEADS, G, B_HD).astype(jnp.float32)
        logits = jnp.einsum('bqngd,bqjnd->bqngj', qg, kg.astype(jnp.float32)) * scale
        logits = jnp.where(valid[:, :, None, None, :], logits, -jnp.inf)
        p = jax.nn.softmax(logits, axis=-1)
        o = jnp.einsum('bqngj,bqjnd->bqngd', p, vg.astype(jnp.float32))
        return o.reshape(bsz, qb, B_WIDTH)

    o = lax.map(block, (blocks(q), blocks(qi), blocks(wi), q_pos.reshape(nb, qb)))
    return jnp.moveaxis(o, 0, 1).reshape(bsz, Tq, B_WIDTH)


def trunk_layer(x, c, pos, s0, k_past, v_past, ki_past,
                w_mod, b_mod, norm1, w_in, lb, g_norm_a, w_out, norm2, w_ff1, w_ff2):
    bsz, T = x.shape[:2]
    mod = (jax.nn.silu(c) @ w_mod + b_mod)[:, None, :]
    sh1, sc1, g1, sh2, sc2, g2 = jnp.split(mod, 6, axis=-1)
    h = rmsnorm(x, norm1) * (1.0 + sc1) + sh1
    z = h @ w_in
    qa, fa, ia, ga, qB, kB, vB, qI, kI, wI = split_cols(z)
    o_a, S = hgrn2_mix(qa.reshape(bsz, T, A_HEADS, A_DK), fa.reshape(bsz, T, A_HEADS, A_DK),
                       ia.reshape(bsz, T, A_HEADS, A_DV), ga.reshape(bsz, T, A_HEADS, A_DV),
                       lb, s0, g_norm_a)
    qB = partial_rope(qB.reshape(bsz, T, B_HEADS, B_HD), pos)
    kB = partial_rope(kB.reshape(bsz, T, B_KV_HEADS, B_HD), pos)
    vB = vB.reshape(bsz, T, B_KV_HEADS, B_HD)
    qI = partial_rope(qI.reshape(bsz, T, IDX_HEADS, IDX_DIM), pos)
    kI = partial_rope(kI[:, :, None, :], pos)[:, :, 0, :]
    wI = wI * ((IDX_HEADS * IDX_DIM) ** -0.5)
    if k_past is None:
        k_all, v_all, ki_all = kB, vB, kI
    else:
        k_all = jnp.concatenate([k_past.astype(kB.dtype), kB], axis=1)
        v_all = jnp.concatenate([v_past.astype(vB.dtype), vB], axis=1)
        ki_all = jnp.concatenate([ki_past.astype(kI.dtype), kI], axis=1)
    o_b = dsa_attend(qB, k_all, v_all, qI, ki_all, wI, pos)
    mix = jnp.concatenate([o_a.astype(x.dtype), o_b.astype(x.dtype)], axis=-1) @ w_out
    x = x + g1 * mix
    h2 = rmsnorm(x, norm2) * (1.0 + sc2) + sh2
    x = x + g2 * (jnp.square(jax.nn.relu(h2 @ w_ff1)) @ w_ff2)
    return x, kB, vB, kI, S


def setup_inputs(seed: int = 0) -> dict:
    key = jax.random.key(seed)
    ks = jax.random.split(key, 20)
    f32 = jnp.float32

    def nrm(k, shape, s):
        return jax.random.normal(k, shape, f32) * s

    return {
        "x_prompt": nrm(ks[0], (BATCH, SEQ, D_MODEL), 1.0),
        "x_sample": nrm(ks[1], (DEC_BATCH, DEC_SEQ, D_MODEL), 1.0),
        "cache_k": nrm(ks[2], (DEPTH, DEC_BATCH, PAST_LEN, B_KV_HEADS, B_HD), 1.0),
        "cache_v": nrm(ks[3], (DEPTH, DEC_BATCH, PAST_LEN, B_KV_HEADS, B_HD), 1.0),
        "cache_k_idx": nrm(ks[4], (DEPTH, DEC_BATCH, PAST_LEN, IDX_DIM), 1.0),
        "state_hgrn": nrm(ks[5], (DEPTH, DEC_BATCH, A_HEADS, A_DK, A_DV), 0.5),
        "c_prompt": nrm(ks[6], (BATCH, D_MODEL), 1.0),
        "c_sample": nrm(ks[7], (DEC_BATCH, D_MODEL), 1.0),
        "w_mod": nrm(ks[8], (DEPTH, D_MODEL, 6 * D_MODEL), 0.2 * D_MODEL ** -0.5),
        "b_mod": nrm(ks[9], (DEPTH, 6 * D_MODEL), 0.02),
        "norm1": 1.0 + nrm(ks[10], (DEPTH, D_MODEL), 0.02),
        "w_in": nrm(ks[11], (DEPTH, D_MODEL, IN_WIDTH), D_MODEL ** -0.5),
        "lb_logits": nrm(ks[12], (DEPTH + 1, A_HEADS * A_DK), 0.5),
        "g_norm_a": 1.0 + nrm(ks[13], (DEPTH, A_WIDTH), 0.02),
        "w_out": nrm(ks[14], (DEPTH, MIX_WIDTH, D_MODEL), MIX_WIDTH ** -0.5),
        "norm2": 1.0 + nrm(ks[15], (DEPTH, D_MODEL), 0.02),
        "w_ff1": nrm(ks[16], (DEPTH, D_MODEL, D_FF), D_MODEL ** -0.5),
        "w_ff2": nrm(ks[17], (DEPTH, D_FF, D_MODEL), D_FF ** -0.5),
        "norm_f": 1.0 + nrm(ks[18], (D_MODEL,), 0.02),
    }


def reference(x_prompt, x_sample, cache_k, cache_v, cache_k_idx, state_hgrn, c_prompt, c_sample,
              w_mod, b_mod, norm1, w_in, lb_logits, g_norm_a, w_out, norm2, w_ff1, w_ff2, norm_f):
    lb_all = jnp.cumsum(jax.nn.softmax(lb_logits.astype(jnp.float32), axis=0), axis=0)
    past = cache_k.shape[2]
    pos_p = jnp.arange(x_prompt.shape[1])
    pos_s = past + jnp.arange(x_sample.shape[1])
    hp, hs = x_prompt, x_sample
    kp_l, vp_l, kip_l, sp_l = [], [], [], []
    ks_l, vs_l, kis_l, ss_l = [], [], [], []
    for l in range(DEPTH):
        lw = (w_mod[l], b_mod[l], norm1[l], w_in[l], lb_all[l].reshape(A_HEADS, A_DK),
              g_norm_a[l], w_out[l], norm2[l], w_ff1[l], w_ff2[l])
        s0 = jnp.zeros((hp.shape[0], A_HEADS, A_DK, A_DV), jnp.float32)
        hp, kp, vp, kip, sp = trunk_layer(hp, c_prompt, pos_p, s0, None, None, None, *lw)
        hs, k_s, v_s, ki_s, s_s = trunk_layer(hs, c_sample, pos_s, state_hgrn[l],
                                              cache_k[l], cache_v[l], cache_k_idx[l], *lw)
        kp_l.append(kp); vp_l.append(vp); kip_l.append(kip); sp_l.append(sp)
        ks_l.append(k_s); vs_l.append(v_s); kis_l.append(ki_s); ss_l.append(s_s)
    y_prompt = rmsnorm(hp, norm_f)
    y_sample = rmsnorm(hs, norm_f)
    return (y_prompt, y_sample,
            jnp.stack(kp_l), jnp.stack(vp_l), jnp.stack(kip_l), jnp.stack(sp_l),
            jnp.stack(ks_l), jnp.stack(vs_l), jnp.stack(kis_l), jnp.stack(ss_l))
```

```cpp
#include <hip/hip_runtime.h>
#include <hip/hip_cooperative_groups.h>
#include <cstdio>
namespace cg = cooperative_groups;

#define LAS __attribute__((address_space(3)))
typedef unsigned short bf16_t;
typedef short bf16x8 __attribute__((ext_vector_type(8)));
typedef float f32x4 __attribute__((ext_vector_type(4)));
typedef unsigned u32x4 __attribute__((ext_vector_type(4)));
typedef unsigned u32x2 __attribute__((ext_vector_type(2)));

constexpr int D = 1024, TP = 2048, TS = 64, TKS = 2112;
constexpr int MP = 16384, MT = 16896;
constexpr int NIN = 3656, NINP = 3840, DFF = 4096;
constexpr int NTHREADS = 512;
constexpr int LDS_BYTES = 163840;

constexpr size_t OFF_Y = 0, OFF_KP = 17301504, OFF_VP = 21495808, OFF_KIP = 25690112, OFF_HP = 26738688,
                 OFF_KS = 27262976, OFF_VS = 27394048, OFF_KIS = 27525120, OFF_HS = 27557888;

constexpr size_t WS_WTIN = 0;
constexpr size_t WS_WTOUT = WS_WTIN + (size_t)NINP * D * 2;
constexpr size_t WS_WTF1 = WS_WTOUT + (size_t)D * D * 2;
constexpr size_t WS_WTF2 = WS_WTF1 + (size_t)DFF * D * 2;
constexpr size_t WS_MOD = WS_WTF2 + (size_t)D * DFF * 2;
constexpr size_t WS_ROPE = WS_MOD + (size_t)16 * 6144 * 4;
constexpr size_t WS_LB = WS_ROPE + (size_t)TKS * 16 * 4;
constexpr size_t WS_QUEUE = WS_LB + 512 * 4;
constexpr size_t WS_BAR = WS_QUEUE + 256;
constexpr size_t WS_H = WS_BAR + 16384;
constexpr size_t WS_R = WS_H + (size_t)MT * D * 2;
constexpr size_t WS_QA = WS_R;
constexpr size_t WS_LFA = WS_QA + (size_t)MT * 512 * 2;
constexpr size_t WS_VA = WS_LFA + (size_t)MT * 512 * 4;
constexpr size_t WS_GA = WS_VA + (size_t)MT * 512 * 2;
constexpr size_t WS_QB = WS_GA + (size_t)MT * 512 * 2;
constexpr size_t WS_QI = WS_QB + (size_t)MT * 512 * 2;
constexpr size_t WS_KBP = WS_QI + (size_t)MT * 512 * 2;
constexpr size_t WS_KBS = WS_KBP + (size_t)8 * TP * 256 * 2;
constexpr size_t WS_VTP = WS_KBS + (size_t)8 * TKS * 256 * 2;
constexpr size_t WS_VTS = WS_VTP + (size_t)8 * 256 * TP * 2;
constexpr size_t WS_KIP = WS_VTS + (size_t)8 * 256 * TKS * 2;
constexpr size_t WS_KIS = WS_KIP + (size_t)8 * TP * 64 * 2;
constexpr size_t WS_WI = WS_KIS + (size_t)8 * TKS * 64 * 2;
constexpr size_t WS_REND = WS_WI + (size_t)MT * 8 * 4;
constexpr size_t WS_U = WS_R;
constexpr size_t WS_UEND = WS_U + (size_t)MT * DFF * 2;
constexpr size_t WS_END = (WS_REND > WS_UEND ? WS_REND : WS_UEND);
static_assert(WS_END <= (size_t)256 * 1024 * 1024, "workspace too large");

struct Params {
    const float* in[19];
    float* out;
    unsigned char* ws;
    int tail[8];
    int ntail, ksplit;
    int wave, pad;
};

typedef float f32x2 __attribute__((ext_vector_type(2)));
typedef __bf16 bf16x2_t __attribute__((ext_vector_type(2)));
__device__ __forceinline__ unsigned pk2(float lo, float hi) { const f32x2 v = {lo, hi}; return __builtin_bit_cast(unsigned, __builtin_convertvector(v, bf16x2_t)); }
__device__ __forceinline__ bf16_t f2bf(float f) { return (bf16_t)(pk2(f, 0.f) & 0xffffu); }
__device__ __forceinline__ float bf2f(bf16_t b) { return __uint_as_float(((unsigned)b) << 16); }
__device__ __forceinline__ float silu_f(float x) { return x / (1.f + __expf(-x)); }
__device__ __forceinline__ float wave_sum(float v) {
#pragma unroll
    for (int o = 32; o >= 1; o >>= 1) v += __shfl_xor(v, o);
    return v;
}
#define GAS __attribute__((address_space(1)))
template <class T> __device__ __forceinline__ T ldg32(const void* base, unsigned off) { return *(const GAS T*)((const GAS char*)base + off); }
template <class T> __device__ __forceinline__ T ldgp(const void* ptr) { return *(const GAS T*)ptr; }
template <class T> __device__ __forceinline__ void stgp(void* ptr, T v) { *(GAS T*)ptr = v; }
__device__ __forceinline__ unsigned opaque(unsigned v) { asm volatile("" : "+v"(v)); return v; }
__device__ __forceinline__ int lane_id() { unsigned m = ~0u; asm volatile("" : "+s"(m)); return (int)__builtin_amdgcn_mbcnt_hi(m, __builtin_amdgcn_mbcnt_lo(m, 0u)); }
__device__ __forceinline__ int otid(int wave) { return (int)opaque((unsigned)((wave << 6) | lane_id())); }
__device__ __forceinline__ f32x4 mfma16(bf16x8 a, bf16x8 b, f32x4 c) { return __builtin_amdgcn_mfma_f32_16x16x32_bf16(a, b, c, 0, 0, 0); }

namespace pg8 {
constexpr int BM = 256, BK = 64, HALF = 128, HTB = HALF * BK * 2, STAGE_BYTES = 8 * HTB, NXCD = 8, WGM = 8;
__device__ __forceinline__ int lds_byte(int r, int c) { const int st = (r >> 4) * 2 + (c >> 5), rr = r & 15, cc = c & 31, ob = rr * 64 + cc * 2; return st * 1024 + (ob ^ (((ob >> 9) & 1) << 5)); }
__device__ __forceinline__ void stage_rc(int b, int& R, int& C) { const int st = b / 1024, sb = b % 1024, swz = sb ^ (((sb >> 9) & 1) << 5); R = (st >> 1) * 16 + swz / 64; C = (st & 1) * 32 + (swz % 64) / 2; }
__device__ __forceinline__ int perm32(int rho) { const int n = rho >> 4, i = rho & 15; return 8 * (i >> 2) + 4 * n + (i & 3); }
struct Unit { int pm, pn, k0, nt, split, tidx; };
struct Gemm { const bf16_t* A; const bf16_t* Bt; int M, N, K, wave; };
struct StaticOrder {
    int nM, nN, nwg, G, c, ntFull, KS, nfull;
    __device__ __forceinline__ void init(int M, int N, int K, int G_, int c_, int ksplit) {
        nM = M / BM; nN = N / BM; nwg = nM * nN; G = G_; c = c_; ntFull = K / BK; KS = ksplit; nfull = ksplit > 1 ? (nwg / G) * G : nwg; }
    __device__ __forceinline__ void tile(int wgid, Unit& u) const {
        { const int q = nwg / NXCD, r = nwg % NXCD, xcd = wgid % NXCD, off = wgid / NXCD; wgid = (xcd < r ? xcd * (q + 1) : r * (q + 1) + (xcd - r) * q) + off; }
        const int nig = WGM * nN, gid = wgid / nig, fm = gid * WGM, gsz = (nM - fm) < WGM ? (nM - fm) : WGM;
        u.pm = fm + ((wgid % nig) % gsz); u.pn = (wgid % nig) / gsz; }
    __device__ __forceinline__ bool next(int i, Unit& u) const {
        const int L = i * G + c, L2 = L - nfull;
        const bool full = L < nfull;
        if (!full && L2 >= (nwg - nfull) * KS) return false;
        const int wg = full ? L : nfull + L2 / KS;
        const int nts = full ? ntFull : ntFull / KS;
        const int k0 = full ? 0 : (L2 % KS) * nts * BK;
        int wgid = wg;
        { const int q = nwg / NXCD, r = nwg % NXCD, xcd = wgid % NXCD, off = wgid / NXCD; wgid = (xcd < r ? xcd * (q + 1) : r * (q + 1) + (xcd - r) * q) + off; }
        const int nig = WGM * nN, gid = wgid / nig, fm = gid * WGM, gsz = (nM - fm) < WGM ? (nM - fm) : WGM;
        u.pm = fm + ((wgid % nig) % gsz); u.pn = (wgid % nig) / gsz; u.k0 = k0; u.nt = nts; u.split = full ? 0 : 1; u.tidx = full ? 0 : L2 / KS;
        return true;
    }
};
template <class Epi>
__device__ __forceinline__ void gemm_phase(LAS unsigned char* lds, const Gemm g, const StaticOrder& S, const Epi& E) {
    const int tid = otid(g.wave), wid = __builtin_amdgcn_readfirstlane(tid >> 6), lane = tid & 63, wr = wid >> 2, wc = wid & 3, fr = lane & 15, fq = lane >> 4;
    const int K = g.K;
    unsigned voffA[2], voffB[2];
#pragma unroll
    for (int i = 0; i < 2; ++i) { int R, C; stage_rc(tid * 16 + i * 8192, R, C); const int Rb = Epi::PERM ? ((R & ~31) + perm32(R & 31)) : R;
        voffA[i] = (unsigned)(R * K + C) * 2u; voffB[i] = (unsigned)(Rb * K + C) * 2u; }
    const size_t kstep = (size_t)(BK * 2);
    const size_t hstep = (size_t)HALF * K * 2;
    const size_t tstep = 2 * hstep;
    const unsigned ldsw = (unsigned)wid * 1024u;
    const int aoff = lds_byte(wr * 64 + fr, fq * 8), boff = lds_byte(wc * 32 + fr, fq * 8);
#define PG8_SA(b, h) (((b) * 2 + (h)) * HTB)
#define PG8_SB(b, h) ((4 + (b) * 2 + (h)) * HTB)
#define PG8_STAGE(bufoff, gbase, voff) do { _Pragma("unroll") for (int _i = 0; _i < 2; ++_i) \
        __builtin_amdgcn_global_load_lds((const unsigned*)((const char*)(gbase) + (voff)[_i]), (LAS unsigned*)(lds + (bufoff) + ldsw + _i * 8192), 16, 0, 0); } while (0)
#define PG8_LDA(dst, b, h) do { _Pragma("unroll") for (int m = 0; m < 4; ++m) _Pragma("unroll") for (int k = 0; k < 2; ++k) dst[m][k] = *(const LAS bf16x8*)(lds + PG8_SA(b, h) + aoff + m * 2048 + k * 1024); } while (0)
#define PG8_LDB(dst, b, h) do { _Pragma("unroll") for (int n = 0; n < 2; ++n) _Pragma("unroll") for (int k = 0; k < 2; ++k) dst[n][k] = *(const LAS bf16x8*)(lds + PG8_SB(b, h) + boff + n * 2048 + k * 1024); } while (0)
#define PG8_MMA(ai, bj, At, Bt) do { __builtin_amdgcn_s_setprio(1); _Pragma("unroll") for (int m = 0; m < 4; ++m) _Pragma("unroll") for (int n = 0; n < 2; ++n) _Pragma("unroll") for (int k = 0; k < 2; ++k) \
        acc[ai][bj][m][n] = __builtin_amdgcn_mfma_f32_16x16x32_bf16(Bt[n][k], At[m][k], acc[ai][bj][m][n], 0, 0, 0); __builtin_amdgcn_s_setprio(0); } while (0)
#define PG8_WAIT_V(n) asm volatile("s_waitcnt vmcnt(" #n ")" ::: "memory")
#define PG8_WAIT_L(n) asm volatile("s_waitcnt lgkmcnt(" #n ")" ::: "memory")
#define PG8_BAR __builtin_amdgcn_s_barrier()
#define PG8_SCHED __builtin_amdgcn_sched_barrier(0)
    Unit cur, nxt; int ui = 0;
    if (!S.next(0, cur)) return;
    f32x4 acc[2][2][4][2];
#pragma unroll
    for (int a = 0; a < 2; ++a)
#pragma unroll
        for (int b = 0; b < 2; ++b)
#pragma unroll
            for (int m = 0; m < 4; ++m)
#pragma unroll
                for (int n = 0; n < 2; ++n) acc[a][b][m][n] = (f32x4){0.f, 0.f, 0.f, 0.f};
    bf16x8 At[4][2], B0[2][2], B1[2][2];
    const char* cA = (const char*)g.A + (size_t)cur.pm * tstep + (size_t)cur.k0 * 2; const char* cB = (const char*)g.Bt + (size_t)cur.pn * tstep + (size_t)cur.k0 * 2;
    PG8_STAGE(PG8_SB(0, 0), cB, voffB); PG8_STAGE(PG8_SA(0, 0), cA, voffA); PG8_STAGE(PG8_SB(0, 1), cB + hstep, voffB); PG8_STAGE(PG8_SA(0, 1), cA + hstep, voffA);
    if (wr == 1) PG8_BAR;
    PG8_WAIT_V(4); PG8_BAR;
    PG8_STAGE(PG8_SB(1, 0), cB + kstep, voffB); PG8_STAGE(PG8_SA(1, 0), cA + kstep, voffA); PG8_STAGE(PG8_SB(1, 1), cB + hstep + kstep, voffB);
    PG8_WAIT_V(6); PG8_BAR;
    for (;;) {
        const bool has_next = S.next(ui + 1, nxt);
        const char* nA = has_next ? (const char*)g.A + (size_t)nxt.pm * tstep + (size_t)nxt.k0 * 2 : cA; const char* nB = has_next ? (const char*)g.Bt + (size_t)nxt.pn * tstep + (size_t)nxt.k0 * 2 : cB;
        const int nt = cur.nt;
        for (int t = 0; t < nt; t += 2) {
            const bool last = (t == nt - 2);
            const char* a1 = cA + (size_t)(t + 1) * kstep;
            const char* a2 = last ? nA : cA + (size_t)(t + 2) * kstep; const char* b2 = last ? nB : cB + (size_t)(t + 2) * kstep;
            const char* a3 = a2 + kstep; const char* b3 = b2 + kstep;
            PG8_LDB(B0, 0, 0); PG8_SCHED; PG8_LDA(At, 0, 0); PG8_STAGE(PG8_SA(1, 1), a1 + hstep, voffA);
            PG8_WAIT_L(8); PG8_BAR; PG8_WAIT_L(0); PG8_MMA(0, 0, At, B0); PG8_BAR; PG8_SCHED;
            PG8_LDB(B1, 0, 1); PG8_STAGE(PG8_SB(0, 0), b2, voffB);
            PG8_BAR; PG8_WAIT_L(0); PG8_MMA(0, 1, At, B1); PG8_BAR;
            PG8_LDA(At, 0, 1); PG8_STAGE(PG8_SA(0, 0), a2, voffA);
            PG8_BAR; PG8_WAIT_L(0); PG8_MMA(1, 0, At, B0); PG8_BAR; PG8_SCHED;
            PG8_STAGE(PG8_SB(0, 1), b2 + hstep, voffB);
            PG8_WAIT_V(6); PG8_BAR; PG8_MMA(1, 1, At, B1); PG8_BAR;
            PG8_LDB(B0, 1, 0); PG8_SCHED; PG8_LDA(At, 1, 0); PG8_STAGE(PG8_SA(0, 1), a2 + hstep, voffA);
            PG8_WAIT_L(8); PG8_BAR; PG8_WAIT_L(0); PG8_MMA(0, 0, At, B0); PG8_BAR; PG8_SCHED;
            PG8_LDB(B1, 1, 1); PG8_STAGE(PG8_SB(1, 0), b3, voffB);
            PG8_BAR; PG8_WAIT_L(0); PG8_MMA(0, 1, At, B1); PG8_BAR;
            PG8_LDA(At, 1, 1); PG8_STAGE(PG8_SA(1, 0), a3, voffA);
            PG8_BAR; PG8_WAIT_L(0); PG8_MMA(1, 0, At, B0); PG8_BAR; PG8_SCHED;
            PG8_STAGE(PG8_SB(1, 1), b3 + hstep, voffB);
            PG8_WAIT_V(6); PG8_BAR; PG8_MMA(1, 1, At, B1); PG8_BAR;
        }
        E(acc, cur, wr, wc, fr, fq);
        if (!has_next) break;
#pragma unroll
        for (int a = 0; a < 2; ++a)
#pragma unroll
            for (int b = 0; b < 2; ++b)
#pragma unroll
                for (int m = 0; m < 4; ++m)
#pragma unroll
                    for (int n = 0; n < 2; ++n) acc[a][b][m][n] = (f32x4){0.f, 0.f, 0.f, 0.f};
        cur = nxt; cA = nA; cB = nB; ++ui;
    }
    PG8_WAIT_V(0);
    if (wr == 0) PG8_BAR;
    PG8_BAR;
#undef PG8_SA
#undef PG8_SB
#undef PG8_STAGE
#undef PG8_LDA
#undef PG8_LDB
#undef PG8_MMA
#undef PG8_WAIT_V
#undef PG8_WAIT_L
#undef PG8_BAR
#undef PG8_SCHED
}
}

__device__ __forceinline__ int row_pos(int row) { return row < MP ? (row & (TP - 1)) : TP + ((row - MP) & (TS - 1)); }
__device__ __forceinline__ int row_seq(int row) { return row < MP ? (row >> 11) : 8 + ((row - MP) >> 6); }

struct EpiIn {
    static constexpr bool PERM = true;
    float* out; unsigned char* ws; const float* lbl;
    template <int SEG>
    __device__ __forceinline__ void run(const f32x4 (&acc)[2][2][4][2], const pg8::Unit& u, int wr, int wc, int fr, int fq) const {
        const float* rope = (const float*)(ws + WS_ROPE);
#pragma unroll
        for (int ai = 0; ai < 2; ++ai)
#pragma unroll
            for (int m = 0; m < 4; ++m) {
                const int row = (int)opaque((unsigned)(u.pm * 256 + ai * 128 + wr * 64 + m * 16 + fr));
#pragma unroll
                for (int bj = 0; bj < 2; ++bj) {
                    const int c0 = u.pn * 256 + bj * 128 + wc * 32 + 8 * fq;
                    float v[8];
#pragma unroll
                    for (int i = 0; i < 4; ++i) { v[i] = acc[ai][bj][m][0][i]; v[4 + i] = acc[ai][bj][m][1][i]; }
                    if (SEG == 4 || SEG == 5 || SEG == 7 || SEG == 8) {
                        const bool doRope = (SEG == 8) ? (bj == 0 && wc == 0) : ((wc & 1) == 0);
                        if (doRope) {
                            const int pos = row_pos(row);
                            const f32x4* cs = (const f32x4*)(rope + (size_t)pos * 16);
                            f32x4 t0 = cs[0], t1 = cs[1], t2 = cs[2], t3 = cs[3];
                            const float cc[8] = {t0[0], t0[2], t1[0], t1[2], t2[0], t2[2], t3[0], t3[2]};
                            const float ss[8] = {t0[1], t0[3], t1[1], t1[3], t2[1], t2[3], t3[1], t3[3]};
#pragma unroll
                            for (int i = 0; i < 8; ++i) {
                                const float o = __shfl_xor(v[i], 16);
                                const float r0 = v[i] * cc[i] - o * ss[i], r1 = v[i] * cc[i] + o * ss[i];
                                v[i] = (fq == 0) ? r0 : ((fq == 1) ? r1 : v[i]);
                            }
                        }
                    }
                    if (SEG == 0 || SEG == 3) {
                        const int cc = c0 - (SEG == 0 ? 0 : 1536);
#pragma unroll
                        for (int i = 0; i < 8; ++i) v[i] = silu_f(v[i]);
                        u32x4 o = {pk2(v[0], v[1]), pk2(v[2], v[3]), pk2(v[4], v[5]), pk2(v[6], v[7])};
                        *(u32x4*)(ws + (SEG == 0 ? WS_QA : WS_GA) + ((size_t)row * 512 + cc) * 2) = o;
                    } else if (SEG == 1) {
                        const int cc = c0 - 512;
                        const f32x4 lba = *(const f32x4*)(lbl + cc), lbb = *(const f32x4*)(lbl + cc + 4);
                        float r[8];
#pragma unroll
                        for (int i = 0; i < 8; ++i) {
                            const float lb = i < 4 ? lba[i & 3] : lbb[i & 3];
                            const float sg = 1.f / (1.f + __expf(-v[i]));
                            r[i] = __logf(lb + (1.f - lb) * sg);
                        }
                        float* dst = (float*)(ws + WS_LFA) + (size_t)row * 512 + cc;
                        *(f32x4*)dst = (f32x4){r[0], r[1], r[2], r[3]}; *(f32x4*)(dst + 4) = (f32x4){r[4], r[5], r[6], r[7]};
                    } else if (SEG == 2) {
                        const int cc = c0 - 1024;
                        u32x4 o = {pk2(v[0], v[1]), pk2(v[2], v[3]), pk2(v[4], v[5]), pk2(v[6], v[7])};
                        *(u32x4*)(ws + WS_VA + ((size_t)row * 512 + cc) * 2) = o;
                    } else if (SEG == 4) {
                        const int cc = c0 - 2048;
                        const float qs = 0.18033688011112042f;
                        u32x4 o = {pk2(v[0] * qs, v[1] * qs), pk2(v[2] * qs, v[3] * qs), pk2(v[4] * qs, v[5] * qs), pk2(v[6] * qs, v[7] * qs)};
                        *(u32x4*)(ws + WS_QB + ((size_t)row * 512 + cc) * 2) = o;
                    } else if (SEG == 7) {
                        const int cc = c0 - 3072;
                        u32x4 o = {pk2(v[0], v[1]), pk2(v[2], v[3]), pk2(v[4], v[5]), pk2(v[6], v[7])};
                        *(u32x4*)(ws + WS_QI + ((size_t)row * 512 + cc) * 2) = o;
                    } else if (SEG == 5) {
                        const int cc = c0 - 2560;
                        float* dst = row < MP ? out + OFF_KP + (size_t)row * 256 + cc : out + OFF_KS + (size_t)(row - MP) * 256 + cc;
                        *(f32x4*)dst = (f32x4){v[0], v[1], v[2], v[3]}; *(f32x4*)(dst + 4) = (f32x4){v[4], v[5], v[6], v[7]};
                        u32x4 o = {pk2(v[0], v[1]), pk2(v[2], v[3]), pk2(v[4], v[5]), pk2(v[6], v[7])};
                        size_t kr = row < MP ? (size_t)row : (size_t)((row - MP) >> 6) * TKS + TP + ((row - MP) & 63);
                        *(u32x4*)(ws + (row < MP ? WS_KBP : WS_KBS) + (kr * 256 + cc) * 2) = o;
                    } else if (SEG == 6) {
                        const int cc = c0 - 2816;
                        float* dst = row < MP ? out + OFF_VP + (size_t)row * 256 + cc : out + OFF_VS + (size_t)(row - MP) * 256 + cc;
                        *(f32x4*)dst = (f32x4){v[0], v[1], v[2], v[3]}; *(f32x4*)(dst + 4) = (f32x4){v[4], v[5], v[6], v[7]};
                        if (row < MP) {
                            const int b = row >> 11, t = row & 2047;
                            bf16_t* vt = (bf16_t*)(ws + WS_VTP) + ((size_t)b * 256 + cc) * TP + t;
#pragma unroll
                            for (int i = 0; i < 8; ++i) vt[(size_t)i * TP] = f2bf(v[i]);
                        } else {
                            const int b = (row - MP) >> 6, t = TP + ((row - MP) & 63);
                            bf16_t* vt = (bf16_t*)(ws + WS_VTS) + ((size_t)b * 256 + cc) * TKS + t;
#pragma unroll
                            for (int i = 0; i < 8; ++i) vt[(size_t)i * TKS] = f2bf(v[i]);
                        }
                    } else if (SEG == 8) {
                        if (bj == 0) {
                            const int cc = wc * 32 + 8 * fq;
                            if (wc < 2) {
                                float* dst = row < MP ? out + OFF_KIP + (size_t)row * 64 + cc : out + OFF_KIS + (size_t)(row - MP) * 64 + cc;
                                *(f32x4*)dst = (f32x4){v[0], v[1], v[2], v[3]}; *(f32x4*)(dst + 4) = (f32x4){v[4], v[5], v[6], v[7]};
                                u32x4 o = {pk2(v[0], v[1]), pk2(v[2], v[3]), pk2(v[4], v[5]), pk2(v[6], v[7])};
                                size_t kr = row < MP ? (size_t)row : (size_t)((row - MP) >> 6) * TKS + TP + ((row - MP) & 63);
                                *(u32x4*)(ws + (row < MP ? WS_KIP : WS_KIS) + (kr * 64 + cc) * 2) = o;
                            } else if (wc == 2 && fq == 0) {
                                const float sc = 0.044194173824159216f;
                                float* dst = (float*)(ws + WS_WI) + (size_t)row * 8;
                                *(f32x4*)dst = (f32x4){v[0] * sc, v[1] * sc, v[2] * sc, v[3] * sc}; *(f32x4*)(dst + 4) = (f32x4){v[4] * sc, v[5] * sc, v[6] * sc, v[7] * sc};
                            }
                        }
                    }
                }
            }
    }
    __device__ __forceinline__ void operator()(const f32x4 (&acc)[2][2][4][2], const pg8::Unit& u, int wr, int wc, int fr, int fq) const {
        const int pn = u.pn;
        if (pn < 2) run<0>(acc, u, wr, wc, fr, fq);
        else if (pn < 4) run<1>(acc, u, wr, wc, fr, fq);
        else if (pn < 6) run<2>(acc, u, wr, wc, fr, fq);
        else if (pn < 8) run<3>(acc, u, wr, wc, fr, fq);
        else if (pn < 10) run<4>(acc, u, wr, wc, fr, fq);
        else if (pn == 10) run<5>(acc, u, wr, wc, fr, fq);
        else if (pn == 11) run<6>(acc, u, wr, wc, fr, fq);
        else if (pn < 14) run<7>(acc, u, wr, wc, fr, fq);
        else run<8>(acc, u, wr, wc, fr, fq);
    }
};

template <int MODE> struct EpiRes {
    static constexpr bool PERM = false;
    const float* xp; const float* xs; float* dst; const float* mod; float* part;
    __device__ __forceinline__ void operator()(const f32x4 (&acc)[2][2][4][2], const pg8::Unit& u, int wr, int wc, int fr, int fq) const {
        if (u.split) {
            const int ks = u.k0 / (u.nt * 64);
            float* pb = part + (size_t)(u.tidx * (MODE == 0 ? 4 : 16) + ks) * 65536;
#pragma unroll
            for (int ai = 0; ai < 2; ++ai)
#pragma unroll
                for (int m = 0; m < 4; ++m) {
                    const int rloc = (int)opaque((unsigned)(ai * 128 + wr * 64 + m * 16 + fr));
#pragma unroll
                    for (int bj = 0; bj < 2; ++bj)
#pragma unroll
                        for (int n = 0; n < 2; ++n) *(f32x4*)(pb + rloc * 256 + bj * 128 + wc * 32 + n * 16 + 4 * fq) = acc[ai][bj][m][n];
                }
            return;
        }
#pragma unroll
        for (int ai = 0; ai < 2; ++ai)
#pragma unroll
            for (int m = 0; m < 4; ++m) {
                const int row = (int)opaque((unsigned)(u.pm * 256 + ai * 128 + wr * 64 + m * 16 + fr));
                const float* gate = mod + (size_t)row_seq(row) * 6144 + (MODE == 0 ? 2048 : 5120);
                const float* src = MODE == 0 ? (row < MP ? xp + (size_t)row * D : xs + (size_t)(row - MP) * D) : dst + (size_t)row * D;
                float* drow = dst + (size_t)row * D;
#pragma unroll
                for (int bj = 0; bj < 2; ++bj)
#pragma unroll
                    for (int n = 0; n < 2; ++n) {
                        const int c = u.pn * 256 + bj * 128 + wc * 32 + n * 16 + 4 * fq;
                        const f32x4 g = *(const f32x4*)(gate + c), x = *(const f32x4*)(src + c);
                        *(f32x4*)(drow + c) = x + g * acc[ai][bj][m][n];
                    }
            }
    }
};

struct EpiFF1 {
    static constexpr bool PERM = true;
    bf16_t* U;
    __device__ __forceinline__ void operator()(const f32x4 (&acc)[2][2][4][2], const pg8::Unit& u, int wr, int wc, int fr, int fq) const {
#pragma unroll
        for (int ai = 0; ai < 2; ++ai)
#pragma unroll
            for (int m = 0; m < 4; ++m) {
                const int row = (int)opaque((unsigned)(u.pm * 256 + ai * 128 + wr * 64 + m * 16 + fr));
#pragma unroll
                for (int bj = 0; bj < 2; ++bj) {
                    const int c0 = u.pn * 256 + bj * 128 + wc * 32 + 8 * fq;
                    float v[8];
#pragma unroll
                    for (int i = 0; i < 4; ++i) { v[i] = acc[ai][bj][m][0][i]; v[4 + i] = acc[ai][bj][m][1][i]; }
#pragma unroll
                    for (int i = 0; i < 8; ++i) { const float r = fmaxf(v[i], 0.f); v[i] = r * r; }
                    u32x4 o = {pk2(v[0], v[1]), pk2(v[2], v[3]), pk2(v[4], v[5]), pk2(v[6], v[7])};
                    *(u32x4*)(U + (size_t)row * DFF + c0) = o;
                }
            }
    }
};

__device__ __forceinline__ void transpose_tile(int wave, const float* src, int ldin, int ncols_valid, bf16_t* dst, int ldout, int k0, int n0, float* tile) {
    const int t = otid(wave);
    {
        const int c4 = (t & 31) * 4, r = t >> 5;
        const int n = n0 + c4;
        f32x4 v[4];
#pragma unroll
        for (int i = 0; i < 4; ++i) v[i] = (n < ncols_valid) ? *(const f32x4*)(src + (size_t)(k0 + r + 16 * i) * ldin + n) : (f32x4){0.f, 0.f, 0.f, 0.f};
#pragma unroll
        for (int i = 0; i < 4; ++i) {
            float* tr = tile + (r + 16 * i) * 129 + c4;
            tr[0] = v[i][0]; tr[1] = v[i][1]; tr[2] = v[i][2]; tr[3] = v[i][3];
        }
    }
    __syncthreads();
#pragma unroll
    for (int h = 0; h < 2; ++h) {
        const int id = t + 512 * h, ko = id & 7, n = id >> 3;
        const float* tc = tile + (ko * 8) * 129 + n;
        const u32x4 o = {pk2(tc[0], tc[129]), pk2(tc[2 * 129], tc[3 * 129]), pk2(tc[4 * 129], tc[5 * 129]), pk2(tc[6 * 129], tc[7 * 129])};
        *(u32x4*)(dst + (size_t)(n0 + n) * ldout + k0 + ko * 8) = o;
    }
    __syncthreads();
}

__device__ __forceinline__ void mod_item(const Params& p, int it, float* smem) {
    float* sc = smem;
    float* red = smem + 16384;
    const int tid = otid(p.wave);
    for (int idx = tid; idx < 16384; idx += NTHREADS) {
        const int s = idx & 15, k = idx >> 4;
        const float c = s < 8 ? p.in[6][s * 1024 + k] : p.in[7][(s - 8) * 1024 + k];
        sc[idx] = silu_f(c);
    }
    __syncthreads();
    const int cl = tid & 63, kg = tid >> 6, col = it * 64 + cl;
    float acc[16];
#pragma unroll
    for (int s = 0; s < 16; ++s) acc[s] = 0.f;
    const float* wm = p.in[8];
#pragma unroll 16
    for (int kk = 0; kk < 128; ++kk) {
        const int k = kg * 128 + kk;
        const float w = wm[(size_t)k * 6144 + col];
        const f32x4* sv = (const f32x4*)(sc + k * 16);
#pragma unroll
        for (int q = 0; q < 4; ++q) { const f32x4 s4 = sv[q]; acc[q * 4 + 0] += w * s4[0]; acc[q * 4 + 1] += w * s4[1]; acc[q * 4 + 2] += w * s4[2]; acc[q * 4 + 3] += w * s4[3]; }
    }
#pragma unroll
    for (int s = 0; s < 16; ++s) red[(kg * 16 + s) * 64 + cl] = acc[s];
    __syncthreads();
    float* mod = (float*)(p.ws + WS_MOD);
    for (int idx = tid; idx < 1024; idx += NTHREADS) {
        const int s = idx >> 6, c = idx & 63;
        float sum = p.in[9][it * 64 + c];
#pragma unroll
        for (int g = 0; g < 8; ++g) sum += red[(g * 16 + s) * 64 + c];
        mod[(size_t)s * 6144 + it * 64 + c] = sum;
    }
    __syncthreads();
}

__device__ __forceinline__ void sincos_acc(float ang, float& c, float& s) {
    const double a = (double)ang;
    const double q = rint(a * 0.63661977236758134308);
    double r = a - q * 1.5707963267948966192;
    r -= q * 6.123233995736766036e-17;
    const double r2 = r * r;
    double sp = r * (1.0 + r2 * (-1.0 / 6 + r2 * (1.0 / 120 + r2 * (-1.0 / 5040 + r2 * (1.0 / 362880 + r2 * (-1.0 / 39916800 + r2 * (1.0 / 6227020800.0)))))));
    double cp = 1.0 + r2 * (-0.5 + r2 * (1.0 / 24 + r2 * (-1.0 / 720 + r2 * (1.0 / 40320 + r2 * (-1.0 / 3628800 + r2 * (1.0 / 479001600.0 + r2 * (-1.0 / 87178291200.0)))))));
    const int qi = ((int)(long long)q) & 3;
    double cc = (qi == 0) ? cp : (qi == 1) ? -sp : (qi == 2) ? -cp : sp;
    double ss = (qi == 0) ? sp : (qi == 1) ? cp : (qi == 2) ? -sp : -cp;
    c = (float)cc; s = (float)ss;
}

__device__ __forceinline__ void phase0(const Params& p, float* smem) {
    const int tid = otid(p.wave);
    constexpr int N_MOD = 96, N_WIN = 480, N_WOUT = 128, N_F1 = 512, N_F2 = 512, N_CV = 512, N_CK = 256, N_CKI = 64, N_ROPE = 33;
    constexpr int TOTAL = N_MOD + N_WIN + N_WOUT + N_F1 + N_F2 + N_CV + N_CK + N_CKI + N_ROPE;
    if (blockIdx.x == 0 && tid == 0) *(int*)(p.ws + WS_QUEUE) = 0;
    int* counter = (int*)(p.ws + WS_QUEUE) + 16;
    volatile int* slot = (volatile int*)((unsigned char*)smem + LDS_BYTES - 16);
    int nxt_item = 0;
    if (tid == 0) nxt_item = atomicAdd(counter, 1);
    for (;;) {
        if (tid == 0) *slot = nxt_item;
        __syncthreads();
        const int item = *slot;
        __syncthreads();
        if (item >= TOTAL) break;
        if (tid == 0) nxt_item = atomicAdd(counter, 1);
        int it = item;
        if (it < N_MOD) { mod_item(p, it, smem); continue; }
        it -= N_MOD;
        if (it < N_WIN) { transpose_tile(p.wave, p.in[11], NIN, NIN, (bf16_t*)(p.ws + WS_WTIN), D, (it / 30) * 64, (it % 30) * 128, smem); continue; }
        it -= N_WIN;
        if (it < N_WOUT) { transpose_tile(p.wave, p.in[14], D, D, (bf16_t*)(p.ws + WS_WTOUT), D, (it / 8) * 64, (it % 8) * 128, smem); continue; }
        it -= N_WOUT;
        if (it < N_F1) { transpose_tile(p.wave, p.in[16], DFF, DFF, (bf16_t*)(p.ws + WS_WTF1), D, (it / 32) * 64, (it % 32) * 128, smem); continue; }
        it -= N_F1;
        if (it < N_F2) { transpose_tile(p.wave, p.in[17], D, D, (bf16_t*)(p.ws + WS_WTF2), DFF, (it / 8) * 64, (it % 8) * 128, smem); continue; }
        it -= N_F2;
        if (it < N_CV) { const int b = it >> 6, r = it & 63; transpose_tile(p.wave, p.in[3] + (size_t)b * TP * 256, 256, 256, (bf16_t*)(p.ws + WS_VTS) + (size_t)b * 256 * TKS, TKS, (r >> 1) * 64, (r & 1) * 128, smem); continue; }
        it -= N_CV;
        if (it < N_CK) {
#pragma unroll
            for (int rep = 0; rep < 4; ++rep) {
                const size_t e = ((size_t)it * 4 + rep) * 4096 + tid * 8; const int b = (int)(e / ((size_t)TP * 256)); const size_t rem = e % ((size_t)TP * 256);
                const f32x4 a = *(const f32x4*)(p.in[2] + e), c = *(const f32x4*)(p.in[2] + e + 4);
                u32x4 o = {pk2(a[0], a[1]), pk2(a[2], a[3]), pk2(c[0], c[1]), pk2(c[2], c[3])};
                *(u32x4*)(p.ws + WS_KBS + ((size_t)b * TKS * 256 + rem) * 2) = o;
            }
            continue;
        }
        it -= N_CK;
        if (it < N_CKI) {
#pragma unroll
            for (int rep = 0; rep < 4; ++rep) {
                const size_t e = ((size_t)it * 4 + rep) * 4096 + tid * 8; const int b = (int)(e / ((size_t)TP * 64)); const size_t rem = e % ((size_t)TP * 64);
                const f32x4 a = *(const f32x4*)(p.in[4] + e), c = *(const f32x4*)(p.in[4] + e + 4);
                u32x4 o = {pk2(a[0], a[1]), pk2(a[2], a[3]), pk2(c[0], c[1]), pk2(c[2], c[3])};
                *(u32x4*)(p.ws + WS_KIS + ((size_t)b * TKS * 64 + rem) * 2) = o;
            }
            continue;
        }
        it -= N_CKI;
        {
            if (it == 0) { const float l0 = p.in[12][tid], l1 = p.in[12][512 + tid]; ((float*)(p.ws + WS_LB))[tid] = 1.f / (1.f + expf(l1 - l0)); }
            const int e = it * 512 + tid;
            if (e < TKS * 8) {
                const int pos = e >> 3, i = e & 7;
                const float inv = (float)exp(-(double)i * 0.125 * 13.122363377404328);
                const float ang = (float)pos * inv;
                float c, s; sincos_acc(ang, c, s);
                float* rope = (float*)(p.ws + WS_ROPE);
                rope[(size_t)pos * 16 + 2 * i] = c; rope[(size_t)pos * 16 + 2 * i + 1] = s;
            }
        }
    }
}

template <int MODE> __device__ __forceinline__ void norm_phase(const Params& p) {
    const int tn = otid(p.wave); const int lane = tn & 63, wv = tn >> 6;
    const float* mod = (const float*)(p.ws + WS_MOD);
    const float* nw = MODE == 0 ? p.in[10] : (MODE == 1 ? p.in[15] : p.in[18]);
    f32x4 w4[4];
#pragma unroll
    for (int j = 0; j < 4; ++j) w4[j] = *(const f32x4*)(nw + lane * 4 + 256 * j);
    for (int row = blockIdx.x * 8 + wv; row < MT; row += gridDim.x * 8) {
        const float* src = MODE == 0 ? (row < MP ? p.in[0] + (size_t)row * D : p.in[1] + (size_t)(row - MP) * D) : p.out + OFF_Y + (size_t)row * D;
        f32x4 v[4]; float s = 0.f;
#pragma unroll
        for (int j = 0; j < 4; ++j) v[j] = *(const f32x4*)(src + lane * 4 + 256 * j);
        if (MODE != 0 && p.ksplit > 1) {
            const int pm4 = (row >> 8) * 4;
            const float* part = (const float*)(p.ws + (MODE == 1 ? WS_R : WS_H));
            const float* gate = mod + (size_t)row_seq(row) * 6144 + (MODE == 1 ? 2048 : 5120);
#pragma unroll
            for (int j = 0; j < 4; ++j) {
                int hit = -1;
#pragma unroll
                for (int t = 0; t < 8; ++t) hit = (t < p.ntail && p.tail[t] == pm4 + j) ? t : hit;
                if (hit >= 0) {
                    constexpr int NSL = MODE == 1 ? 4 : 16;
                    const float* pp = part + (size_t)hit * NSL * 65536 + (row & 255) * 256 + lane * 4;
                    f32x4 sum = (*(const f32x4*)pp + *(const f32x4*)(pp + 65536)) + (*(const f32x4*)(pp + 2 * 65536) + *(const f32x4*)(pp + 3 * 65536));
#pragma unroll
                    for (int sl = 4; sl < NSL; sl += 4)
                        sum = sum + ((*(const f32x4*)(pp + (size_t)sl * 65536) + *(const f32x4*)(pp + (size_t)(sl + 1) * 65536)) + (*(const f32x4*)(pp + (size_t)(sl + 2) * 65536) + *(const f32x4*)(pp + (size_t)(sl + 3) * 65536)));
                    const f32x4 g = *(const f32x4*)(gate + lane * 4 + 256 * j);
                    if (MODE == 1) {
                        const float* xrow = row < MP ? p.in[0] + (size_t)row * D : p.in[1] + (size_t)(row - MP) * D;
                        v[j] = *(const f32x4*)(xrow + lane * 4 + 256 * j) + g * sum;
                        *(f32x4*)(p.out + OFF_Y + (size_t)row * D + lane * 4 + 256 * j) = v[j];
                    } else v[j] = v[j] + g * sum;
                }
            }
        }
#pragma unroll
        for (int j = 0; j < 4; ++j) s += v[j][0] * v[j][0] + v[j][1] * v[j][1] + v[j][2] * v[j][2] + v[j][3] * v[j][3];
        s = wave_sum(s);
        const float rstd = rsqrtf(s * (1.f / D) + 1e-6f);
        if (MODE == 2) {
            float* dst = p.out + OFF_Y + (size_t)row * D;
#pragma unroll
            for (int j = 0; j < 4; ++j) *(f32x4*)(dst + lane * 4 + 256 * j) = v[j] * rstd * w4[j];
        } else {
            const float* mrow = mod + (size_t)row_seq(row) * 6144 + (MODE == 0 ? 0 : 3072);
            bf16_t* dst = (bf16_t*)(p.ws + WS_H) + (size_t)row * D;
#pragma unroll
            for (int j = 0; j < 4; ++j) {
                const f32x4 sh = *(const f32x4*)(mrow + lane * 4 + 256 * j), sc = *(const f32x4*)(mrow + 1024 + lane * 4 + 256 * j);
                const f32x4 r = v[j] * rstd * w4[j] * (sc + 1.f) + sh;
                u32x2 o = {pk2(r[0], r[1]), pk2(r[2], r[3])};
                *(u32x2*)(dst + lane * 4 + 256 * j) = o;
            }
        }
    }
}

constexpr int HG_LF = 0;
constexpr int HG_TOT = HG_LF + 64 * 128 * 4;
constexpr int HG_BREL = HG_TOT + 4 * 128 * 4;
constexpr int HG_QE = HG_BREL + 4 * 128 * 4;
constexpr int HG_KE = HG_QE + 64 * 272;
constexpr int HG_KET = HG_KE + 64 * 272;
constexpr int HG_VT = HG_KET + 128 * 144;
constexpr int HG_ST = HG_VT + 128 * 144;
constexpr int HG_PP = HG_ST + 128 * 272;
constexpr int HG_SSQ = HG_PP + 64 * 144;
constexpr int HG_RS = HG_SSQ + 8 * 64 * 4;
constexpr int HG_ER = HG_RS + 64 * 4;
constexpr int HG_EBR = HG_ER + 128 * 4;
constexpr int HG_END = HG_EBR + 128 * 4;
static_assert(HG_END <= LDS_BYTES, "hgrn LDS");

__device__ __forceinline__ void hgrn_unit(const Params& p, unsigned char* smem, int grp, int b, int hh) {
    const int tid = otid(p.wave), lane = tid & 63, w = tid >> 6, l15 = lane & 15, lg = lane >> 4;
    const int nch = grp == 0 ? TP / 64 : 1;
    const int row0 = grp == 0 ? b * TP : MP + b * TS;
    float* LF = (float*)(smem + HG_LF); float* TOT = (float*)(smem + HG_TOT); float* BREL = (float*)(smem + HG_BREL); float* SSQ = (float*)(smem + HG_SSQ);
    float* RS = (float*)(smem + HG_RS); float* ER = (float*)(smem + HG_ER); float* EBR = (float*)(smem + HG_EBR);
    const bf16_t* qA = (const bf16_t*)(p.ws + WS_QA); const float* lfA = (const float*)(p.ws + WS_LFA);
    const bf16_t* vA = (const bf16_t*)(p.ws + WS_VA); const bf16_t* gA = (const bf16_t*)(p.ws + WS_GA);
    bf16_t* mix = (bf16_t*)(p.ws + WS_H);
    f32x4 Sacc[8];
    if (grp == 0) {
#pragma unroll
        for (int kt = 0; kt < 8; ++kt) Sacc[kt] = (f32x4){0.f, 0.f, 0.f, 0.f};
    } else {
        const float* s0 = p.in[5] + ((size_t)(b * 4 + hh) * 128) * 128;
#pragma unroll
        for (int kt = 0; kt < 8; ++kt)
#pragma unroll
            for (int j = 0; j < 4; ++j) Sacc[kt][j] = s0[(size_t)(kt * 16 + lg * 4 + j) * 128 + 16 * w + l15];
    }
    const int t0 = tid >> 4, oc = tid & 15;
    const int kc = tid & 127, part = tid >> 7;
    f32x4 nlf[2][2]; u32x4 nq[2], nv[2], ng[2];
    {
#pragma unroll
        for (int h = 0; h < 2; ++h) {
            const unsigned eo = (unsigned)((row0 + t0 + 32 * h) * 512 + hh * 128 + oc * 8);
            nlf[h][0] = ldg32<f32x4>(lfA, eo * 4u); nlf[h][1] = ldg32<f32x4>(lfA, eo * 4u + 16u);
            nq[h] = ldg32<u32x4>(qA, eo * 2u); nv[h] = ldg32<u32x4>(vA, eo * 2u); ng[h] = ldg32<u32x4>(gA, eo * 2u);
        }
    }
    for (int c = 0; c < nch; ++c) {
        const int tok0 = row0 + c * 64;
        f32x4 clf[2][2]; u32x4 cq[2], cg[2];
#pragma unroll
        for (int h = 0; h < 2; ++h) {
            const int t = t0 + 32 * h;
            const int tsw = (((t >> 3) ^ (oc & 7)) << 4) + (t & 7) * 2;
            clf[h][0] = nlf[h][0]; clf[h][1] = nlf[h][1]; cq[h] = nq[h]; cg[h] = ng[h];
            *(f32x4*)(LF + t * 128 + oc * 8) = clf[h][0]; *(f32x4*)(LF + t * 128 + oc * 8 + 4) = clf[h][1];
#pragma unroll
            for (int i = 0; i < 4; ++i) {
                *(bf16_t*)(smem + HG_VT + (oc * 8 + 2 * i) * 144 + tsw) = (bf16_t)(nv[h][i] & 0xffffu);
                *(bf16_t*)(smem + HG_VT + (oc * 8 + 2 * i + 1) * 144 + tsw) = (bf16_t)(nv[h][i] >> 16);
            }
        }
        if (c + 1 < nch) {
#pragma unroll
            for (int h = 0; h < 2; ++h) {
                const unsigned eo = (unsigned)((tok0 + 64 + t0 + 32 * h) * 512 + hh * 128 + oc * 8);
                nlf[h][0] = ldg32<f32x4>(lfA, eo * 4u); nlf[h][1] = ldg32<f32x4>(lfA, eo * 4u + 16u);
                nq[h] = ldg32<u32x4>(qA, eo * 2u); nv[h] = ldg32<u32x4>(vA, eo * 2u); ng[h] = ldg32<u32x4>(gA, eo * 2u);
            }
        }
        __syncthreads();
        {
            float run = 0.f;
#pragma unroll
            for (int i = 0; i < 16; ++i) { const int t = part * 16 + i; run += LF[t * 128 + kc]; LF[t * 128 + kc] = run; }
            TOT[part * 128 + kc] = run;
        }
        __syncthreads();
        if (tid < 128) {
            const float t0s = TOT[tid], t1s = TOT[128 + tid], t2s = TOT[256 + tid], t3s = TOT[384 + tid];
            const float r = LF[31 * 128 + tid] + t0s;
            const float bl = t0s + t1s + t2s + t3s;
            ER[tid] = __expf(r); EBR[tid] = __expf(bl - r);
            BREL[tid] = -r; BREL[128 + tid] = t0s - r; BREL[256 + tid] = t0s + t1s - r; BREL[384 + tid] = t0s + t1s + t2s - r;
        }
        __syncthreads();
#pragma unroll
        for (int h = 0; h < 2; ++h) {
            const int t = t0 + 32 * h, pt = t >> 4;
            const int tsw = (((t >> 3) ^ (oc & 7)) << 4) + (t & 7) * 2;
            const f32x4 b0 = *(const f32x4*)(LF + t * 128 + oc * 8), b1 = *(const f32x4*)(LF + t * 128 + oc * 8 + 4);
            const f32x4 r0 = *(const f32x4*)(BREL + pt * 128 + oc * 8), r1 = *(const f32x4*)(BREL + pt * 128 + oc * 8 + 4);
            float qe[8], ke[8];
#pragma unroll
            for (int i = 0; i < 8; ++i) {
                const float bmr = (i < 4 ? b0[i & 3] : b1[i & 3]) + (i < 4 ? r0[i & 3] : r1[i & 3]);
                const float lfr = i < 4 ? clf[h][0][i & 3] : clf[h][1][i & 3];
                const unsigned qw = cq[h][i >> 1];
                const float q = __uint_as_float((i & 1) ? (qw & 0xffff0000u) : (qw << 16));
                qe[i] = q * __expf(bmr);
                ke[i] = (1.f - __expf(lfr)) * __expf(-bmr);
            }
            const u32x4 qp = {pk2(qe[0], qe[1]), pk2(qe[2], qe[3]), pk2(qe[4], qe[5]), pk2(qe[6], qe[7])};
            const u32x4 kp = {pk2(ke[0], ke[1]), pk2(ke[2], ke[3]), pk2(ke[4], ke[5]), pk2(ke[6], ke[7])};
            *(u32x4*)(smem + HG_QE + t * 272 + oc * 16) = qp;
            *(u32x4*)(smem + HG_KE + t * 272 + oc * 16) = kp;
#pragma unroll
            for (int i = 0; i < 4; ++i) {
                *(bf16_t*)(smem + HG_KET + (oc * 8 + 2 * i) * 144 + tsw) = (bf16_t)(kp[i] & 0xffffu);
                *(bf16_t*)(smem + HG_KET + (oc * 8 + 2 * i + 1) * 144 + tsw) = (bf16_t)(kp[i] >> 16);
            }
        }
#pragma unroll
        for (int kt = 0; kt < 8; ++kt) {
            const f32x4 er = *(const f32x4*)(ER + kt * 16 + lg * 4);
            Sacc[kt] = Sacc[kt] * er;
            u32x2 o = {pk2(Sacc[kt][0], Sacc[kt][1]), pk2(Sacc[kt][2], Sacc[kt][3])};
            *(u32x2*)(smem + HG_ST + (16 * w + l15) * 272 + (kt * 16 + lg * 4) * 2) = o;
        }
        __syncthreads();
#pragma unroll
        for (int e = 0; e < 2; ++e) {
            const int tile = 2 * w + e, ti = tile >> 2, si = tile & 3;
            f32x4 a = (f32x4){0.f, 0.f, 0.f, 0.f};
            if (si <= ti) {
#pragma unroll
                for (int kk = 0; kk < 4; ++kk) {
                    const bf16x8 af = *(const bf16x8*)(smem + HG_QE + (ti * 16 + l15) * 272 + (kk * 32 + lg * 8) * 2);
                    const bf16x8 bfr = *(const bf16x8*)(smem + HG_KE + (si * 16 + l15) * 272 + (kk * 32 + lg * 8) * 2);
                    a = mfma16(af, bfr, a);
                }
            }
#pragma unroll
            for (int j = 0; j < 4; ++j) {
                const int t = ti * 16 + lg * 4 + j, s = si * 16 + l15;
                const float val = (s <= t && si <= ti) ? a[j] : 0.f;
                *(bf16_t*)(smem + HG_PP + t * 144 + s * 2) = f2bf(val);
            }
        }
        __syncthreads();
        f32x4 oacc[4];
        {
            bf16x8 vf[2];
#pragma unroll
            for (int kk = 0; kk < 2; ++kk) vf[kk] = *(const bf16x8*)(smem + HG_VT + (16 * w + l15) * 144 + (((kk * 4 + lg) ^ (((16 * w + l15) >> 3) & 7)) << 4));
#pragma unroll
            for (int tt = 0; tt < 4; ++tt) {
                f32x4 a = (f32x4){0.f, 0.f, 0.f, 0.f};
#pragma unroll
                for (int kk = 0; kk < 2; ++kk) {
                    const bf16x8 pf = *(const bf16x8*)(smem + HG_PP + (tt * 16 + l15) * 144 + (kk * 32 + lg * 8) * 2);
                    a = mfma16(pf, vf[kk], a);
                }
#pragma unroll
                for (int kk = 0; kk < 4; ++kk) {
                    const bf16x8 qf = *(const bf16x8*)(smem + HG_QE + (tt * 16 + l15) * 272 + (kk * 32 + lg * 8) * 2);
                    const bf16x8 sf = *(const bf16x8*)(smem + HG_ST + (16 * w + l15) * 272 + (kk * 32 + lg * 8) * 2);
                    a = mfma16(qf, sf, a);
                }
                oacc[tt] = a;
            }
#pragma unroll
            for (int kt = 0; kt < 8; ++kt) {
#pragma unroll
                for (int kk = 0; kk < 2; ++kk) {
                    const bf16x8 kf = *(const bf16x8*)(smem + HG_KET + (kt * 16 + l15) * 144 + (((kk * 4 + lg) ^ (((kt * 16 + l15) >> 3) & 7)) << 4));
                    Sacc[kt] = mfma16(kf, vf[kk], Sacc[kt]);
                }
                const f32x4 ebr = *(const f32x4*)(EBR + kt * 16 + lg * 4);
                Sacc[kt] = Sacc[kt] * ebr;
            }
#pragma unroll
            for (int tt = 0; tt < 4; ++tt)
#pragma unroll
                for (int j = 0; j < 4; ++j) {
                    float s = oacc[tt][j] * oacc[tt][j];
                    s += __shfl_xor(s, 1); s += __shfl_xor(s, 2); s += __shfl_xor(s, 4); s += __shfl_xor(s, 8);
                    if (l15 == 0) SSQ[w * 64 + tt * 16 + lg * 4 + j] = s;
                }
        }
        __syncthreads();
        if (tid < 64) {
            float ss = 0.f;
#pragma unroll
            for (int ww = 0; ww < 8; ++ww) ss += SSQ[ww * 64 + tid];
            RS[tid] = rsqrtf(ss * (1.f / 128.f) + 1e-6f);
        }
        __syncthreads();
        {
            const float gn = p.in[13][hh * 128 + 16 * w + l15];
#pragma unroll
            for (int tt = 0; tt < 4; ++tt) {
                const f32x4 rs = *(const f32x4*)(RS + tt * 16 + lg * 4);
#pragma unroll
                for (int j = 0; j < 4; ++j)
                    *(bf16_t*)(smem + HG_QE + (tt * 16 + lg * 4 + j) * 272 + (16 * w + l15) * 2) = f2bf(oacc[tt][j] * rs[j] * gn);
            }
        }
        __syncthreads();
#pragma unroll
        for (int h = 0; h < 2; ++h) {
            const int t = t0 + 32 * h;
            const int tsw = (((t >> 3) ^ (oc & 7)) << 4) + (t & 7) * 2;
            const u32x4 ov = *(const u32x4*)(smem + HG_QE + t * 272 + oc * 16);
            u32x4 res;
#pragma unroll
            for (int i = 0; i < 4; ++i) {
                const float o0 = __uint_as_float(ov[i] << 16) * __uint_as_float(cg[h][i] << 16);
                const float o1 = __uint_as_float(ov[i] & 0xffff0000u) * __uint_as_float(cg[h][i] & 0xffff0000u);
                res[i] = pk2(o0, o1);
            }
            stgp<u32x4>((char*)mix + ((size_t)(tok0 + t) * D + hh * 128 + oc * 8) * 2, res);
        }
    }
    float* so = p.out + (grp == 0 ? OFF_HP : OFF_HS) + ((size_t)(b * 4 + hh) * 128) * 128;
#pragma unroll
    for (int kt = 0; kt < 8; ++kt)
#pragma unroll
        for (int j = 0; j < 4; ++j) so[(size_t)(kt * 16 + lg * 4 + j) * 128 + 16 * w + l15] = Sacc[kt][j];
    __syncthreads();
}

constexpr int DS_CNT = 0;
constexpr int DS_ML = DS_CNT + 2 * 8 * 16 * 4;
constexpr int DS_OW = DS_ML + 8 * 2 * 16 * 8;
constexpr int DS_END = DS_OW + 8 * 2 * 64 * 16 * 4;
constexpr int DS_BM = 0;
constexpr int DS_ML2 = 4352;
constexpr int DS_OW2 = DS_ML2 + 4 * 2 * 16 * 8;
static_assert(DS_END <= LDS_BYTES, "dsa LDS");

__device__ __forceinline__ unsigned sortable(float f) { const unsigned u = __float_as_uint(f); return (u & 0x80000000u) ? ~u : (u | 0x80000000u); }

__device__ __forceinline__ void dsa_item(const Params& p, unsigned char* smem, int grp, int b, int c, int sub) {
    const int tid = otid(p.wave), lane = tid & 63, w = tid >> 6, l15 = lane & 15, lg = lane >> 4;
    const int nk = grp == 0 ? (c + 1) * 64 : TKS;
    const int ntiles = nk >> 4;
    const int ldv = grp == 0 ? TP : TKS;
    const bf16_t* kI = (const bf16_t*)(p.ws + (grp == 0 ? WS_KIP : WS_KIS)) + (size_t)b * ldv * 64;
    const bf16_t* kB = (const bf16_t*)(p.ws + (grp == 0 ? WS_KBP : WS_KBS)) + (size_t)b * ldv * 256;
    const bf16_t* vT = (const bf16_t*)(p.ws + (grp == 0 ? WS_VTP : WS_VTS)) + (size_t)b * 256 * ldv;
    const bf16_t* qI = (const bf16_t*)(p.ws + WS_QI); const bf16_t* qB = (const bf16_t*)(p.ws + WS_QB);
    const float* wI = (const float*)(p.ws + WS_WI);
    bf16_t* mix = (bf16_t*)(p.ws + WS_H);
    int* CNT = (int*)(smem + DS_CNT); float* ML = (float*)(smem + DS_ML); float* OW = (float*)(smem + DS_OW);
    const int qr = (grp == 0 ? b * TP + c * 64 : MP + b * TS) + sub * 16;
    const int nblk = nk >> 5;
    const int krow = 8 * (l15 >> 2) + (l15 & 3);
    const unsigned kIoff = (unsigned)(((w * 32 + krow) * 64 + lg * 8) * 2);
    const unsigned kBoff = (unsigned)(((w * 32 + krow) * 256 + lg * 8) * 2);
    const unsigned vToff = (unsigned)((l15 * ldv + w * 32 + lg * 8) * 2);
    unsigned msk[3] = {0u, 0u, 0u};
    {
        unsigned keys[72];
        {
            bf16x8 bq[8][2]; float wq[8];
#pragma unroll
            for (int h = 0; h < 8; ++h) {
#pragma unroll
                for (int kk = 0; kk < 2; ++kk) bq[h][kk] = ldgp<bf16x8>(qI + (size_t)(qr + l15) * 512 + h * 64 + kk * 32 + lg * 8);
                wq[h] = ldgp<float>(wI + (size_t)(qr + l15) * 8 + h);
            }
            bf16x8 ka[2][2];
#define KI_SLOT_OFF(i) ((unsigned)((i) >> 1) * (8u * 32u * 128u) + (unsigned)((i) & 1) * (4u * 128u))
            if (w < nblk) { const unsigned ko = opaque(kIoff); ka[0][0] = ldg32<bf16x8>(kI, ko); ka[0][1] = ldg32<bf16x8>(kI, ko + 64u); }
            __builtin_amdgcn_sched_barrier(0);
#pragma unroll
            for (int i = 0; i < 18; ++i) {
                if (w + 8 * (i >> 1) < nblk) {
                    if (i + 1 < 18 && (w + 8 * ((i + 1) >> 1) < nblk)) { const unsigned ko = opaque(kIoff) + KI_SLOT_OFF(i + 1); ka[(i + 1) & 1][0] = ldg32<bf16x8>(kI, ko); ka[(i + 1) & 1][1] = ldg32<bf16x8>(kI, ko + 64u); }
                    const bf16x8 a0 = ka[i & 1][0], a1 = ka[i & 1][1];
                    f32x4 sc = (f32x4){0.f, 0.f, 0.f, 0.f};
#pragma unroll
                    for (int h = 0; h < 8; ++h) {
                        f32x4 a = mfma16(a0, bq[h][0], (f32x4){0.f, 0.f, 0.f, 0.f});
                        a = mfma16(a1, bq[h][1], a);
#pragma unroll
                        for (int j = 0; j < 4; ++j) sc[j] += wq[h] * fmaxf(a[j], 0.f);
                    }
#pragma unroll
                    for (int j = 0; j < 4; ++j) keys[i * 4 + j] = sortable(sc[j]);
                } else {
#pragma unroll
                    for (int j = 0; j < 4; ++j) keys[i * 4 + j] = 0u;
                }
                __builtin_amdgcn_sched_barrier(0);
            }
#undef KI_SLOT_OFF
        }
        unsigned thr = 1u;
        if (nk > 256) {
            unsigned* SC = (unsigned*)smem;
            unsigned* THR = (unsigned*)(smem + 16 * 2113 * 4);
#pragma unroll
            for (int i = 0; i < 18; ++i)
                if (w + 8 * (i >> 1) < nblk) {
                    const int kidx = 32 * (w + 8 * (i >> 1)) + 8 * lg + 4 * (i & 1);
#pragma unroll
                    for (int j = 0; j < 4; ++j) SC[l15 * 2113 + kidx + j] = keys[i * 4 + j];
                }
            __syncthreads();
            const int nr = nk >> 6;
#pragma unroll
            for (int qq = 0; qq < 2; ++qq) {
                unsigned myk[33];
#pragma unroll
                for (int r = 0; r < 33; ++r) myk[r] = (r < nr) ? SC[(2 * w + qq) * 2113 + r * 64 + lane] : 0u;
                unsigned t = 0u; int cat = nk;
                for (int bit = 31; bit >= 0; --bit) {
                    const unsigned cand = t | (1u << bit);
                    int cnt = 0;
#pragma unroll
                    for (int r = 0; r < 33; ++r) cnt += (int)__popcll(__ballot(myk[r] >= cand));
                    if (cnt >= 256) { t = cand; cat = cnt; }
                    if (cat == 256) break;
                }
                if (lane == 0) THR[2 * w + qq] = t;
            }
            __syncthreads();
            thr = THR[l15];
        }
#pragma unroll
        for (int i = 0; i < 72; ++i) msk[i >> 5] |= (keys[i] >= thr) ? (1u << (i & 31)) : 0u;
    }
    {
        unsigned char* BM = smem + DS_BM;
#pragma unroll
        for (int ip = 0; ip < 9; ++ip)
            if (w + 8 * ip < nblk) BM[(l15 * 66 + (w + 8 * ip)) * 4 + lg] = (unsigned char)((msk[(8 * ip) >> 5] >> ((8 * ip) & 31)) & 0xffu);
    }
    __syncthreads();
    {
        const int wu = __builtin_amdgcn_readfirstlane(w), n = wu >> 1, half = wu & 1;
        const unsigned char* BM = smem + DS_BM + l15 * 66 * 4 + lg;
        bf16x8 bqB[2][2];
#pragma unroll
        for (int g = 0; g < 2; ++g)
#pragma unroll
            for (int kk = 0; kk < 2; ++kk) bqB[g][kk] = ldgp<bf16x8>(qB + (size_t)(qr + l15) * 512 + (n * 2 + g) * 64 + kk * 32 + lg * 8);
        const unsigned kBc = (unsigned)((krow * 256 + lg * 8) * 2 + n * 128);
        const unsigned vTc = (unsigned)(((n * 64 + l15) * ldv + lg * 8) * 2);
        float mrun[2] = {-1e30f, -1e30f}, lrun[2] = {0.f, 0.f};
        f32x4 O[2][4];
#pragma unroll
        for (int g = 0; g < 2; ++g)
#pragma unroll
            for (int dt = 0; dt < 4; ++dt) O[g][dt] = (f32x4){0.f, 0.f, 0.f, 0.f};
        bf16x8 kf[2][2][2];
        bf16x8 vfb[2][4];
#define DSA_LOAD_BLK(BK, BUF) do { \
            const unsigned _ko = opaque(kBc) + (unsigned)(BK) * (32u * 512u); \
            kf[BUF][0][0] = ldg32<bf16x8>(kB, _ko); kf[BUF][0][1] = ldg32<bf16x8>(kB, _ko + 64u); \
            kf[BUF][1][0] = ldg32<bf16x8>(kB, _ko + 2048u); kf[BUF][1][1] = ldg32<bf16x8>(kB, _ko + 2048u + 64u); \
            _Pragma("unroll") for (int dt = 0; dt < 4; ++dt) vfb[BUF][dt] = ldg32<bf16x8>(vT, opaque(vTc) + (unsigned)(dt * 16 * ldv * 2) + (unsigned)(BK) * 64u); \
        } while (0)
#define DSA_PROCESS(BK, BUF) do { \
            f32x4 lgt[2][2]; \
            _Pragma("unroll") for (int e = 0; e < 2; ++e) _Pragma("unroll") for (int g = 0; g < 2; ++g) { \
                f32x4 a = mfma16(kf[BUF][e][0], bqB[g][0], (f32x4){0.f, 0.f, 0.f, 0.f}); lgt[g][e] = mfma16(kf[BUF][e][1], bqB[g][1], a); } \
            const unsigned sb = BM[(BK) * 4]; \
            _Pragma("unroll") for (int g = 0; g < 2; ++g) { \
                float tmax = -1e30f; \
                _Pragma("unroll") for (int e = 0; e < 2; ++e) _Pragma("unroll") for (int j = 0; j < 4; ++j) tmax = ((sb >> (4 * e + j)) & 1u) ? fmaxf(tmax, lgt[g][e][j]) : tmax; \
                tmax = fmaxf(tmax, __shfl_xor(tmax, 16)); tmax = fmaxf(tmax, __shfl_xor(tmax, 32)); \
                const float mnew = fmaxf(mrun[g], tmax); \
                const float alpha = __builtin_amdgcn_exp2f(mrun[g] - mnew); \
                mrun[g] = mnew; \
                float pv[2][4]; float psum = 0.f; \
                _Pragma("unroll") for (int e = 0; e < 2; ++e) _Pragma("unroll") for (int j = 0; j < 4; ++j) { \
                    pv[e][j] = ((sb >> (4 * e + j)) & 1u) ? __builtin_amdgcn_exp2f(lgt[g][e][j] - mnew) : 0.f; psum += pv[e][j]; } \
                lrun[g] = lrun[g] * alpha + psum; \
                const u32x4 pp = {pk2(pv[0][0], pv[0][1]), pk2(pv[0][2], pv[0][3]), pk2(pv[1][0], pv[1][1]), pk2(pv[1][2], pv[1][3])}; \
                const bf16x8 pf = __builtin_bit_cast(bf16x8, pp); \
                if (!__all(alpha == 1.f)) { _Pragma("unroll") for (int dt = 0; dt < 4; ++dt) O[g][dt] *= alpha; } \
                _Pragma("unroll") for (int dt = 0; dt < 4; ++dt) O[g][dt] = mfma16(vfb[BUF][dt], pf, O[g][dt]); \
            } \
        } while (0)
        const int cnt = (nblk - half + 1) >> 1;
        int Bk = half;
        if (cnt > 0) DSA_LOAD_BLK(Bk, 0);
        for (int it = 0; it < cnt; it += 2) {
            if (it + 1 < cnt) DSA_LOAD_BLK(Bk + 2, 1);
            DSA_PROCESS(Bk, 0);
            if (it + 1 < cnt) {
                if (it + 2 < cnt) DSA_LOAD_BLK(Bk + 4, 0);
                DSA_PROCESS(Bk + 2, 1);
            }
            Bk += 4;
        }
#undef DSA_LOAD_BLK
#undef DSA_PROCESS
        float* ML2 = (float*)(smem + DS_ML2); float* OW2 = (float*)(smem + DS_OW2);
#pragma unroll
        for (int g = 0; g < 2; ++g) { float l = lrun[g]; l += __shfl_xor(l, 16); l += __shfl_xor(l, 32); lrun[g] = l; }
        if (half == 1) {
#pragma unroll
            for (int g = 0; g < 2; ++g) {
                if (lane < 16) { ML2[((n * 2 + g) * 16 + lane) * 2] = mrun[g]; ML2[((n * 2 + g) * 16 + lane) * 2 + 1] = lrun[g]; }
#pragma unroll
                for (int dt = 0; dt < 4; ++dt)
#pragma unroll
                    for (int j = 0; j < 4; ++j) OW2[((n * 2 + g) * 64 + dt * 16 + lg * 4 + j) * 16 + l15] = O[g][dt][j];
            }
        }
        __syncthreads();
        if (half == 0) {
#pragma unroll
            for (int g = 0; g < 2; ++g) {
                const float m2 = ML2[((n * 2 + g) * 16 + l15) * 2], l2 = ML2[((n * 2 + g) * 16 + l15) * 2 + 1];
                const float M = fmaxf(mrun[g], m2);
                const float f1 = __builtin_amdgcn_exp2f(mrun[g] - M), f2 = __builtin_amdgcn_exp2f(m2 - M);
                const float inv = 1.f / (lrun[g] * f1 + l2 * f2);
#pragma unroll
                for (int dt = 0; dt < 4; ++dt) {
                    float o[4];
#pragma unroll
                    for (int j = 0; j < 4; ++j) o[j] = (O[g][dt][j] * f1 + OW2[((n * 2 + g) * 64 + dt * 16 + lg * 4 + j) * 16 + l15] * f2) * inv;
                    const u32x2 ov = {pk2(o[0], o[1]), pk2(o[2], o[3])};
                    stgp<u32x2>(mix + (size_t)(qr + l15) * D + 512 + (n * 2 + g) * 64 + dt * 16 + lg * 4, ov);
                }
            }
        }
    }
}

constexpr int MIX_ITEMS = 64 + 33 * 32;
__device__ __forceinline__ void mixer_phase(const Params& p, unsigned char* smem) {
    int* counter = (int*)(p.ws + WS_QUEUE);
    volatile int* slot = (volatile int*)(smem + LDS_BYTES - 16);
    for (;;) {
        if (threadIdx.x == 0) *slot = atomicAdd(counter, 1);
        __syncthreads();
        const int item = *slot;
        __syncthreads();
        if (item >= MIX_ITEMS) break;
        if (item < 64) {
            hgrn_unit(p, smem, item >> 5, (item & 31) >> 2, item & 3);
        } else {
            const int j = item - 64, rank = j >> 5, bs = j & 31;
            dsa_item(p, smem, rank == 0 ? 1 : 0, bs >> 2, 32 - rank, bs & 3);
        }
        __syncthreads();
    }
}

#define XB_TMO      128
#define XB_XCNT(j)  (256  + 64 * (j))
#define XB_XSUB(j)  (1280 + 64 * (j))
#define XB_XGEN(j)  (2304 + 64 * (j))
#define XB_TOP      3328
#define XB_TOPGEN   3392
#define XCD_BAR_WORDS 3456
#define XB_SPIN_CAP (1u << 18)
__device__ __forceinline__ unsigned xb_ld(unsigned* p)              { return __hip_atomic_load(p, __ATOMIC_RELAXED, __HIP_MEMORY_SCOPE_AGENT); }
__device__ __forceinline__ unsigned xb_add(unsigned* p, unsigned v) { return __hip_atomic_fetch_add(p, v, __ATOMIC_RELAXED, __HIP_MEMORY_SCOPE_AGENT); }
__device__ __forceinline__ unsigned xb_xcc_id() { return (unsigned)__builtin_amdgcn_s_getreg((3 << 11) | 20) & 0xFu; }
#define XB_SPIN(cond, bar) do { unsigned _sp = 0; while (cond) { __builtin_amdgcn_s_sleep(1); \
    if ((++_sp & 255u) == 0u) { if (xb_ld(&(bar)[XB_TMO])) break; if (_sp > XB_SPIN_CAP) { atomicAdd(&(bar)[XB_TMO], 1u); break; } } } } while (0)
struct XcdBarrier { unsigned* bar; unsigned x; volatile LAS unsigned* st; };
__device__ __forceinline__ XcdBarrier xcd_barrier_post(unsigned* bar, volatile LAS unsigned* st) {
    XcdBarrier b; b.bar = bar; b.x = xb_xcc_id(); b.st = st;
    if (threadIdx.x == 0) (void)xb_add(&bar[XB_XCNT(b.x)], 1u);
    return b;
}
__device__ __forceinline__ void xcd_barrier_complete(unsigned* bar, unsigned x, unsigned& nloc, unsigned& nx) {
    const unsigned G = gridDim.x * gridDim.y * gridDim.z;
    unsigned sum, cnt, mine, sp = 0u;
    for (;;) {
        sum = 0u; cnt = 0u; mine = 0u;
#pragma unroll
        for (unsigned j = 0; j < 16; ++j) { const unsigned c = xb_ld(&bar[XB_XCNT(j)]); sum += c; cnt += (c > 0u) ? 1u : 0u; mine = (j == x) ? c : mine; }
        if (sum == G) break;
        __builtin_amdgcn_s_sleep(1);
        if ((++sp & 255u) == 0u) { if (xb_ld(&bar[XB_TMO])) break; if (sp > XB_SPIN_CAP) { atomicAdd(&bar[XB_TMO], 1u); break; } }
    }
    nloc = mine > 0u ? mine : 1u; nx = cnt > 0u ? cnt : 1u;
}
__device__ __forceinline__ void xcd_barrier(const XcdBarrier& b) {
    asm volatile("s_waitcnt vmcnt(0)" ::: "memory");
    __syncthreads();
    if (threadIdx.x == 0) {
        unsigned* bar = b.bar;
        __builtin_amdgcn_s_waitcnt(0);
        unsigned nloc = b.st[0], nx = b.st[1];
        if (nloc == 0u) { xcd_barrier_complete(bar, b.x, nloc, nx); b.st[0] = nloc; b.st[1] = nx; }
        const unsigned old = xb_add(&bar[XB_XSUB(b.x)], 1u);
        const unsigned gen = old / nloc;
        if (old + 1u == (gen + 1u) * nloc) {
            __builtin_amdgcn_fence(__ATOMIC_RELEASE, "agent");
            asm volatile("s_waitcnt vmcnt(0)" ::: "memory");
            const unsigned og = xb_add(&bar[XB_TOP], 1u);
            const unsigned tg = og / nx;
            if (og + 1u == (tg + 1u) * nx) xb_add(&bar[XB_TOPGEN], 1u);
            else XB_SPIN(xb_ld(&bar[XB_TOPGEN]) == tg, bar);
            __builtin_amdgcn_fence(__ATOMIC_ACQUIRE, "agent");
            xb_add(&bar[XB_XGEN(b.x)], 1u);
            asm volatile("s_waitcnt vmcnt(0)" ::: "memory");
        } else {
            XB_SPIN(xb_ld(&bar[XB_XGEN(b.x)]) == gen, bar);
            __builtin_amdgcn_fence(__ATOMIC_ACQUIRE, "agent");
            asm volatile("s_waitcnt vmcnt(0)" ::: "memory");
        }
    }
    __syncthreads();
}

#ifndef ONE_LAUNCH
#define ONE_LAUNCH 1
#endif
template <int PH> __global__ void __launch_bounds__(NTHREADS) fwd_kernel(Params p) {
    extern __shared__ __attribute__((aligned(16))) unsigned char smem[];
    LAS unsigned char* lds = (LAS unsigned char*)smem;
    const int G = (int)gridDim.x, cb = (int)blockIdx.x;
    const int wave_id = __builtin_amdgcn_readfirstlane((int)threadIdx.x >> 6);
    constexpr bool MULTI = (PH & (PH - 1)) != 0;
    volatile LAS unsigned* xst = (volatile LAS unsigned*)(lds + LDS_BYTES - 32);
    if constexpr (MULTI) { if (threadIdx.x == 0) { xst[0] = 0u; xst[1] = 0u; } __syncthreads(); }
    XcdBarrier xb{};
    if constexpr (MULTI) xb = xcd_barrier_post((unsigned*)(p.ws + WS_BAR), xst);
#define GRID_SYNC() do { if constexpr (MULTI) xcd_barrier(xb); } while (0)
#define FRESH(q) Params q = p; q.wave = wave_id; { size_t z_ = 0; asm volatile("" : "+s"(z_)); q.ws = p.ws + z_; q.out = p.out + z_; }
    if constexpr (PH & 1) { FRESH(q); phase0(q, (float*)smem); }
    GRID_SYNC();
    if constexpr (PH & 2) { FRESH(q); norm_phase<0>(q); }
    GRID_SYNC();
    if constexpr (PH & 4) {
        FRESH(q);
        pg8::Gemm g{(const bf16_t*)(q.ws + WS_H), (const bf16_t*)(q.ws + WS_WTIN), MT, NINP, D, q.wave};
        pg8::StaticOrder S; S.init(MT, NINP, D, G, cb, 1);
        EpiIn E{q.out, q.ws, (const float*)(q.ws + WS_LB)};
        pg8::gemm_phase(lds, g, S, E);
    }
    GRID_SYNC();
    if constexpr (PH & 8) { FRESH(q); mixer_phase(q, smem); }
    GRID_SYNC();
    if constexpr (PH & 16) {
        FRESH(q);
        pg8::Gemm g{(const bf16_t*)(q.ws + WS_H), (const bf16_t*)(q.ws + WS_WTOUT), MT, D, D, q.wave};
        pg8::StaticOrder S; S.init(MT, D, D, G, cb, q.ksplit);
        EpiRes<0> E{q.in[0], q.in[1], q.out + OFF_Y, (const float*)(q.ws + WS_MOD), (float*)(q.ws + WS_R)};
        pg8::gemm_phase(lds, g, S, E);
    }
    GRID_SYNC();
    if constexpr (PH & 32) { FRESH(q); norm_phase<1>(q); }
    GRID_SYNC();
    if constexpr (PH & 64) {
        FRESH(q);
        pg8::Gemm g{(const bf16_t*)(q.ws + WS_H), (const bf16_t*)(q.ws + WS_WTF1), MT, DFF, D, q.wave};
        pg8::StaticOrder S; S.init(MT, DFF, D, G, cb, 1);
        EpiFF1 E{(bf16_t*)(q.ws + WS_U)};
        pg8::gemm_phase(lds, g, S, E);
    }
    GRID_SYNC();
    if constexpr (PH & 128) {
        FRESH(q);
        pg8::Gemm g{(const bf16_t*)(q.ws + WS_U), (const bf16_t*)(q.ws + WS_WTF2), MT, D, DFF, q.wave};
        pg8::StaticOrder S; S.init(MT, D, DFF, G, cb, q.ksplit > 1 ? 16 : 1);
        EpiRes<1> E{nullptr, nullptr, q.out + OFF_Y, (const float*)(q.ws + WS_MOD), (float*)(q.ws + WS_H)};
        pg8::gemm_phase(lds, g, S, E);
    }
    GRID_SYNC();
    if constexpr (PH & 256) { FRESH(q); norm_phase<2>(q); }
#undef FRESH
#undef GRID_SYNC
}

template <int PH> static bool prep_kernel() {
    return hipFuncSetAttribute((const void*)fwd_kernel<PH>, hipFuncAttributeMaxDynamicSharedMemorySize, LDS_BYTES) == hipSuccess;
}
template <int PH> static void launch_plain(const Params& p, int grid, hipStream_t stream) {
    hipLaunchKernelGGL(fwd_kernel<PH>, dim3(grid), dim3(NTHREADS), LDS_BYTES, stream, p);
}

extern "C" void kernel_launch(void* const* d_in, const int* in_sizes, int n_in, void* d_out, int out_size, void* d_ws, size_t ws_size, hipStream_t stream) {
    static int grid_blocks = 0;
    if (grid_blocks == 0) {
        if (n_in != 19 || ws_size < WS_END) { fprintf(stderr, "kernel_launch: unexpected n_in %d / ws_size %zu (need %zu)\n", n_in, ws_size, (size_t)WS_END); grid_blocks = -1; return; }
        int dev = 0, cus = 0, per_cu = 0;
        (void)hipGetDevice(&dev);
        (void)hipDeviceGetAttribute(&cus, hipDeviceAttributeMultiprocessorCount, dev);
#if ONE_LAUNCH
        if (!prep_kernel<511>()) { fprintf(stderr, "kernel_launch: hipFuncSetAttribute failed\n"); grid_blocks = -1; return; }
        if (hipOccupancyMaxActiveBlocksPerMultiprocessor(&per_cu, (const void*)fwd_kernel<511>, NTHREADS, LDS_BYTES) != hipSuccess || per_cu < 1) { fprintf(stderr, "kernel_launch: occupancy query failed (%d)\n", per_cu); grid_blocks = -1; return; }
        grid_blocks = cus * per_cu;
#else
        bool ok = prep_kernel<1>() && prep_kernel<2>() && prep_kernel<4>() && prep_kernel<8>() && prep_kernel<16>() && prep_kernel<32>() && prep_kernel<64>() && prep_kernel<128>() && prep_kernel<256>();
        if (!ok) { fprintf(stderr, "kernel_launch: hipFuncSetAttribute failed\n"); grid_blocks = -1; return; }
        (void)per_cu;
        grid_blocks = cus;
#endif
    }
    if (grid_blocks < 0) return;
    Params p{};
    for (int i = 0; i < 19; ++i) p.in[i] = (const float*)d_in[i];
    p.out = (float*)d_out; p.ws = (unsigned char*)d_ws;
    {
        const int nM = MT / 256, nN = 4, nwg = nM * nN, G = grid_blocks, nfull = (nwg / G) * G, ntail = nwg - nfull;
        p.ntail = 0; p.ksplit = 1;
        if (ntail > 0 && ntail <= 8) {
            p.ntail = ntail; p.ksplit = 4;
            for (int t = 0; t < ntail; ++t) {
                int wgid = nfull + t;
                { const int q = nwg / 8, r = nwg % 8, xcd = wgid % 8, off = wgid / 8; wgid = (xcd < r ? xcd * (q + 1) : r * (q + 1) + (xcd - r) * q) + off; }
                const int nig = 8 * nN, gid = wgid / nig, fm = gid * 8, gsz = (nM - fm) < 8 ? (nM - fm) : 8;
                const int pm = fm + ((wgid % nig) % gsz), pn = (wgid % nig) / gsz;
                p.tail[t] = pm * 4 + pn;
            }
        }
    }
#if ONE_LAUNCH
    (void)hipMemsetAsync((unsigned char*)d_ws + WS_QUEUE, 0, 256 + 16384, stream);
    void* args[] = {&p};
    hipError_t e = hipLaunchCooperativeKernel((const void*)fwd_kernel<511>, dim3(grid_blocks), dim3(NTHREADS), args, LDS_BYTES, stream);
    if (e != hipSuccess) fprintf(stderr, "cooperative launch failed: %s (grid %d)\n", hipGetErrorString(e), grid_blocks);
#else
    launch_plain<1>(p, grid_blocks, stream);
    launch_plain<2>(p, grid_blocks, stream);
    launch_plain<4>(p, grid_blocks, stream);
    launch_plain<8>(p, grid_blocks, stream);
    launch_plain<16>(p, grid_blocks, stream);
    launch_plain<32>(p, grid_blocks, stream);
    launch_plain<64>(p, grid_blocks, stream);
    launch_plain<128>(p, grid_blocks, stream);
    launch_plain<256>(p, grid_blocks, stream);
#endif
}
```

```cpp
#include <hip/hip_runtime.h>
#include <hip/hip_cooperative_groups.h>
#include <cstdio>
namespace cg = cooperative_groups;

#define LAS __attribute__((address_space(3)))
typedef unsigned short bf16_t;
typedef short bf16x8 __attribute__((ext_vector_type(8)));
typedef float f32x4 __attribute__((ext_vector_type(4)));
typedef unsigned u32x4 __attribute__((ext_vector_type(4)));
typedef unsigned u32x2 __attribute__((ext_vector_type(2)));

constexpr int D = 1024, TP = 2048, TS = 64, TKS = 2112;
constexpr int MP = 16384, MT = 16896;
constexpr int NIN = 3656, NINP = 3840, DFF = 4096;
constexpr int NTHREADS = 512;
constexpr int LDS_BYTES = 163840;

constexpr size_t OFF_Y = 0, OFF_KP = 17301504, OFF_VP = 21495808, OFF_KIP = 25690112, OFF_HP = 26738688,
                 OFF_KS = 27262976, OFF_VS = 27394048, OFF_KIS = 27525120, OFF_HS = 27557888;

constexpr size_t WS_WTIN = 0;
constexpr size_t WS_WTOUT = WS_WTIN + (size_t)NINP * D * 2;
constexpr size_t WS_WTF1 = WS_WTOUT + (size_t)D * D * 2;
constexpr size_t WS_WTF2 = WS_WTF1 + (size_t)DFF * D * 2;
constexpr size_t WS_MOD = WS_WTF2 + (size_t)D * DFF * 2;
constexpr size_t WS_ROPE = WS_MOD + (size_t)16 * 6144 * 4;
constexpr size_t WS_LB = WS_ROPE + (size_t)TKS * 16 * 4;
constexpr size_t WS_QUEUE = WS_LB + 512 * 4;
constexpr size_t WS_BAR = WS_QUEUE + 256;
constexpr size_t WS_H = WS_BAR + 16384;
constexpr size_t WS_R = WS_H + (size_t)MT * D * 2;
constexpr size_t WS_QA = WS_R;
constexpr size_t WS_LFA = WS_QA + (size_t)MT * 512 * 2;
constexpr size_t WS_VA = WS_LFA + (size_t)MT * 512 * 4;
constexpr size_t WS_GA = WS_VA + (size_t)MT * 512 * 2;
constexpr size_t WS_QB = WS_GA + (size_t)MT * 512 * 2;
constexpr size_t WS_QI = WS_QB + (size_t)MT * 512 * 2;
constexpr size_t WS_KBP = WS_QI + (size_t)MT * 512 * 2;
constexpr size_t WS_KBS = WS_KBP + (size_t)8 * TP * 256 * 2;
constexpr size_t WS_VTP = WS_KBS + (size_t)8 * TKS * 256 * 2;
constexpr size_t WS_VTS = WS_VTP + (size_t)8 * 256 * TP * 2;
constexpr size_t WS_KIP = WS_VTS + (size_t)8 * 256 * TKS * 2;
constexpr size_t WS_KIS = WS_KIP + (size_t)8 * TP * 64 * 2;
constexpr size_t WS_WI = WS_KIS + (size_t)8 * TKS * 64 * 2;
constexpr size_t WS_REND = WS_WI + (size_t)MT * 8 * 4;
constexpr size_t WS_U = WS_R;
constexpr size_t WS_UEND = WS_U + (size_t)MT * DFF * 2;
constexpr size_t WS_END = (WS_REND > WS_UEND ? WS_REND : WS_UEND);
static_assert(WS_END <= (size_t)256 * 1024 * 1024, "workspace too large");

struct Params {
    const float* in[19];
    float* out;
    unsigned char* ws;
    int tail[8];
    int ntail, ksplit;
    int wave, pad;
};

typedef float f32x2 __attribute__((ext_vector_type(2)));
typedef __bf16 bf16x2_t __attribute__((ext_vector_type(2)));
__device__ __forceinline__ unsigned pk2(float lo, float hi) { const f32x2 v = {lo, hi}; return __builtin_bit_cast(unsigned, __builtin_convertvector(v, bf16x2_t)); }
__device__ __forceinline__ bf16_t f2bf(float f) { return (bf16_t)(pk2(f, 0.f) & 0xffffu); }
__device__ __forceinline__ float bf2f(bf16_t b) { return __uint_as_float(((unsigned)b) << 16); }
__device__ __forceinline__ float silu_f(float x) { return x / (1.f + __expf(-x)); }
__device__ __forceinline__ float wave_sum(float v) {
#pragma unroll
    for (int o = 32; o >= 1; o >>= 1) v += __shfl_xor(v, o);
    return v;
}
#define GAS __attribute__((address_space(1)))
template <class T> __device__ __forceinline__ T ldg32(const void* base, unsigned off) { return *(const GAS T*)((const GAS char*)base + off); }
template <class T> __device__ __forceinline__ T ldgp(const void* ptr) { return *(const GAS T*)ptr; }
template <class T> __device__ __forceinline__ void stgp(void* ptr, T v) { *(GAS T*)ptr = v; }
__device__ __forceinline__ unsigned opaque(unsigned v) { asm volatile("" : "+v"(v)); return v; }
__device__ __forceinline__ int lane_id() { unsigned m = ~0u; asm volatile("" : "+s"(m)); return (int)__builtin_amdgcn_mbcnt_hi(m, __builtin_amdgcn_mbcnt_lo(m, 0u)); }
__device__ __forceinline__ int otid(int wave) { return (int)opaque((unsigned)((wave << 6) | lane_id())); }
__device__ __forceinline__ f32x4 mfma16(bf16x8 a, bf16x8 b, f32x4 c) { return __builtin_amdgcn_mfma_f32_16x16x32_bf16(a, b, c, 0, 0, 0); }

namespace pg8 {
constexpr int BM = 256, BK = 64, HALF = 128, HTB = HALF * BK * 2, STAGE_BYTES = 8 * HTB, NXCD = 8, WGM = 8;
__device__ __forceinline__ int lds_byte(int r, int c) { const int st = (r >> 4) * 2 + (c >> 5), rr = r & 15, cc = c & 31, ob = rr * 64 + cc * 2; return st * 1024 + (ob ^ (((ob >> 9) & 1) << 5)); }
__device__ __forceinline__ void stage_rc(int b, int& R, int& C) { const int st = b / 1024, sb = b % 1024, swz = sb ^ (((sb >> 9) & 1) << 5); R = (st >> 1) * 16 + swz / 64; C = (st & 1) * 32 + (swz % 64) / 2; }
__device__ __forceinline__ int perm32(int rho) { const int n = rho >> 4, i = rho & 15; return 8 * (i >> 2) + 4 * n + (i & 3); }
struct Unit { int pm, pn, k0, nt, split, tidx; };
struct Gemm { const bf16_t* A; const bf16_t* Bt; int M, N, K, wave; };
struct StaticOrder {
    int nM, nN, nwg, G, c, ntFull, KS, nfull;
    __device__ __forceinline__ void init(int M, int N, int K, int G_, int c_, int ksplit) {
        nM = M / BM; nN = N / BM; nwg = nM * nN; G = G_; c = c_; ntFull = K / BK; KS = ksplit; nfull = ksplit > 1 ? (nwg / G) * G : nwg; }
    __device__ __forceinline__ void tile(int wgid, Unit& u) const {
        { const int q = nwg / NXCD, r = nwg % NXCD, xcd = wgid % NXCD, off = wgid / NXCD; wgid = (xcd < r ? xcd * (q + 1) : r * (q + 1) + (xcd - r) * q) + off; }
        const int nig = WGM * nN, gid = wgid / nig, fm = gid * WGM, gsz = (nM - fm) < WGM ? (nM - fm) : WGM;
        u.pm = fm + ((wgid % nig) % gsz); u.pn = (wgid % nig) / gsz; }
    __device__ __forceinline__ bool next(int i, Unit& u) const {
        const int L = i * G + c, L2 = L - nfull;
        const bool full = L < nfull;
        if (!full && L2 >= (nwg - nfull) * KS) return false;
        const int wg = full ? L : nfull + L2 / KS;
        const int nts = full ? ntFull : ntFull / KS;
        const int k0 = full ? 0 : (L2 % KS) * nts * BK;
        int wgid = wg;
        { const int q = nwg / NXCD, r = nwg % NXCD, xcd = wgid % NXCD, off = wgid / NXCD; wgid = (xcd < r ? xcd * (q + 1) : r * (q + 1) + (xcd - r) * q) + off; }
        const int nig = WGM * nN, gid = wgid / nig, fm = gid * WGM, gsz = (nM - fm) < WGM ? (nM - fm) : WGM;
        u.pm = fm + ((wgid % nig) % gsz); u.pn = (wgid % nig) / gsz; u.k0 = k0; u.nt = nts; u.split = full ? 0 : 1; u.tidx = full ? 0 : L2 / KS;
        return true;
    }
};
template <class Epi>
__device__ __forceinline__ void gemm_phase(LAS unsigned char* lds, const Gemm g, const StaticOrder& S, const Epi& E) {
    const int tid = otid(g.wave), wid = __builtin_amdgcn_readfirstlane(tid >> 6), lane = tid & 63, wr = wid >> 2, wc = wid & 3, fr = lane & 15, fq = lane >> 4;
    const int K = g.K;
    unsigned voffA[2], voffB[2];
#pragma unroll
    for (int i = 0; i < 2; ++i) { int R, C; stage_rc(tid * 16 + i * 8192, R, C); const int Rb = Epi::PERM ? ((R & ~31) + perm32(R & 31)) : R;
        voffA[i] = (unsigned)(R * K + C) * 2u; voffB[i] = (unsigned)(Rb * K + C) * 2u; }
    const size_t kstep = (size_t)(BK * 2);
    const size_t hstep = (size_t)HALF * K * 2;
    const size_t tstep = 2 * hstep;
    const unsigned ldsw = (unsigned)wid * 1024u;
    const int aoff = lds_byte(wr * 64 + fr, fq * 8), boff = lds_byte(wc * 32 + fr, fq * 8);
#define PG8_SA(b, h) (((b) * 2 + (h)) * HTB)
#define PG8_SB(b, h) ((4 + (b) * 2 + (h)) * HTB)
#define PG8_STAGE(bufoff, gbase, voff) do { _Pragma("unroll") for (int _i = 0; _i < 2; ++_i) \
        __builtin_amdgcn_global_load_lds((const unsigned*)((const char*)(gbase) + (voff)[_i]), (LAS unsigned*)(lds + (bufoff) + ldsw + _i * 8192), 16, 0, 0); } while (0)
#define PG8_LDA(dst, b, h) do { _Pragma("unroll") for (int m = 0; m < 4; ++m) _Pragma("unroll") for (int k = 0; k < 2; ++k) dst[m][k] = *(const LAS bf16x8*)(lds + PG8_SA(b, h) + aoff + m * 2048 + k * 1024); } while (0)
#define PG8_LDB(dst, b, h) do { _Pragma("unroll") for (int n = 0; n < 2; ++n) _Pragma("unroll") for (int k = 0; k < 2; ++k) dst[n][k] = *(const LAS bf16x8*)(lds + PG8_SB(b, h) + boff + n * 2048 + k * 1024); } while (0)
#define PG8_MMA(ai, bj, At, Bt) do { __builtin_amdgcn_s_setprio(1); _Pragma("unroll") for (int m = 0; m < 4; ++m) _Pragma("unroll") for (int n = 0; n < 2; ++n) _Pragma("unroll") for (int k = 0; k < 2; ++k) \
        acc[ai][bj][m][n] = __builtin_amdgcn_mfma_f32_16x16x32_bf16(Bt[n][k], At[m][k], acc[ai][bj][m][n], 0, 0, 0); __builtin_amdgcn_s_setprio(0); } while (0)
#define PG8_WAIT_V(n) asm volatile("s_waitcnt vmcnt(" #n ")" ::: "memory")
#define PG8_WAIT_L(n) asm volatile("s_waitcnt lgkmcnt(" #n ")" ::: "memory")
#define PG8_BAR __builtin_amdgcn_s_barrier()
#define PG8_SCHED __builtin_amdgcn_sched_barrier(0)
    Unit cur, nxt; int ui = 0;
    if (!S.next(0, cur)) return;
    f32x4 acc[2][2][4][2];
#pragma unroll
    for (int a = 0; a < 2; ++a)
#pragma unroll
        for (int b = 0; b < 2; ++b)
#pragma unroll
            for (int m = 0; m < 4; ++m)
#pragma unroll
                for (int n = 0; n < 2; ++n) acc[a][b][m][n] = (f32x4){0.f, 0.f, 0.f, 0.f};
    bf16x8 At[4][2], B0[2][2], B1[2][2];
    const char* cA = (const char*)g.A + (size_t)cur.pm * tstep + (size_t)cur.k0 * 2; const char* cB = (const char*)g.Bt + (size_t)cur.pn * tstep + (size_t)cur.k0 * 2;
    PG8_STAGE(PG8_SB(0, 0), cB, voffB); PG8_STAGE(PG8_SA(0, 0), cA, voffA); PG8_STAGE(PG8_SB(0, 1), cB + hstep, voffB); PG8_STAGE(PG8_SA(0, 1), cA + hstep, voffA);
    if (wr == 1) PG8_BAR;
    PG8_WAIT_V(4); PG8_BAR;
    PG8_STAGE(PG8_SB(1, 0), cB + kstep, voffB); PG8_STAGE(PG8_SA(1, 0), cA + kstep, voffA); PG8_STAGE(PG8_SB(1, 1), cB + hstep + kstep, voffB);
    PG8_WAIT_V(6); PG8_BAR;
    for (;;) {
        const bool has_next = S.next(ui + 1, nxt);
        const char* nA = has_next ? (const char*)g.A + (size_t)nxt.pm * tstep + (size_t)nxt.k0 * 2 : cA; const char* nB = has_next ? (const char*)g.Bt + (size_t)nxt.pn * tstep + (size_t)nxt.k0 * 2 : cB;
        const int nt = cur.nt;
        for (int t = 0; t < nt; t += 2) {
            const bool last = (t == nt - 2);
            const char* a1 = cA + (size_t)(t + 1) * kstep;
            const char* a2 = last ? nA : cA + (size_t)(t + 2) * kstep; const char* b2 = last ? nB : cB + (size_t)(t + 2) * kstep;
            const char* a3 = a2 + kstep; const char* b3 = b2 + kstep;
            PG8_LDB(B0, 0, 0); PG8_SCHED; PG8_LDA(At, 0, 0); PG8_STAGE(PG8_SA(1, 1), a1 + hstep, voffA);
            PG8_WAIT_L(8); PG8_BAR; PG8_WAIT_L(0); PG8_MMA(0, 0, At, B0); PG8_BAR; PG8_SCHED;
            PG8_LDB(B1, 0, 1); PG8_STAGE(PG8_SB(0, 0), b2, voffB);
            PG8_BAR; PG8_WAIT_L(0); PG8_MMA(0, 1, At, B1); PG8_BAR;
            PG8_LDA(At, 0, 1); PG8_STAGE(PG8_SA(0, 0), a2, voffA);
            PG8_BAR; PG8_WAIT_L(0); PG8_MMA(1, 0, At, B0); PG8_BAR; PG8_SCHED;
            PG8_STAGE(PG8_SB(0, 1), b2 + hstep, voffB);
            PG8_WAIT_V(6); PG8_BAR; PG8_MMA(1, 1, At, B1); PG8_BAR;
            PG8_LDB(B0, 1, 0); PG8_SCHED; PG8_LDA(At, 1, 0); PG8_STAGE(PG8_SA(0, 1), a2 + hstep, voffA);
            PG8_WAIT_L(8); PG8_BAR; PG8_WAIT_L(0); PG8_MMA(0, 0, At, B0); PG8_BAR; PG8_SCHED;
            PG8_LDB(B1, 1, 1); PG8_STAGE(PG8_SB(1, 0), b3, voffB);
            PG8_BAR; PG8_WAIT_L(0); PG8_MMA(0, 1, At, B1); PG8_BAR;
            PG8_LDA(At, 1, 1); PG8_STAGE(PG8_SA(1, 0), a3, voffA);
            PG8_BAR; PG8_WAIT_L(0); PG8_MMA(1, 0, At, B0); PG8_BAR; PG8_SCHED;
            PG8_STAGE(PG8_SB(1, 1), b3 + hstep, voffB);
            PG8_WAIT_V(6); PG8_BAR; PG8_MMA(1, 1, At, B1); PG8_BAR;
        }
        E(acc, cur, wr, wc, fr, fq);
        if (!has_next) break;
#pragma unroll
        for (int a = 0; a < 2; ++a)
#pragma unroll
            for (int b = 0; b < 2; ++b)
#pragma unroll
                for (int m = 0; m < 4; ++m)
#pragma unroll
                    for (int n = 0; n < 2; ++n) acc[a][b][m][n] = (f32x4){0.f, 0.f, 0.f, 0.f};
        cur = nxt; cA = nA; cB = nB; ++ui;
    }
    PG8_WAIT_V(0);
    if (wr == 0) PG8_BAR;
    PG8_BAR;
#undef PG8_SA
#undef PG8_SB
#undef PG8_STAGE
#undef PG8_LDA
#undef PG8_LDB
#undef PG8_MMA
#undef PG8_WAIT_V
#undef PG8_WAIT_L
#undef PG8_BAR
#undef PG8_SCHED
}
}

__device__ __forceinline__ int row_pos(int row) { return row < MP ? (row & (TP - 1)) : TP + ((row - MP) & (TS - 1)); }
__device__ __forceinline__ int row_seq(int row) { return row < MP ? (row >> 11) : 8 + ((row - MP) >> 6); }

struct EpiIn {
    static constexpr bool PERM = true;
    float* out; unsigned char* ws; const float* lbl;
    template <int SEG>
    __device__ __forceinline__ void run(const f32x4 (&acc)[2][2][4][2], const pg8::Unit& u, int wr, int wc, int fr, int fq) const {
        const float* rope = (const float*)(ws + WS_ROPE);
#pragma unroll
        for (int ai = 0; ai < 2; ++ai)
#pragma unroll
            for (int m = 0; m < 4; ++m) {
                const int row = (int)opaque((unsigned)(u.pm * 256 + ai * 128 + wr * 64 + m * 16 + fr));
#pragma unroll
                for (int bj = 0; bj < 2; ++bj) {
                    const int c0 = u.pn * 256 + bj * 128 + wc * 32 + 8 * fq;
                    float v[8];
#pragma unroll
                    for (int i = 0; i < 4; ++i) { v[i] = acc[ai][bj][m][0][i]; v[4 + i] = acc[ai][bj][m][1][i]; }
                    if (SEG == 4 || SEG == 5 || SEG == 7 || SEG == 8) {
                        const bool doRope = (SEG == 8) ? (bj == 0 && wc == 0) : ((wc & 1) == 0);
                        if (doRope) {
                            const int pos = row_pos(row);
                            const f32x4* cs = (const f32x4*)(rope + (size_t)pos * 16);
                            f32x4 t0 = cs[0], t1 = cs[1], t2 = cs[2], t3 = cs[3];
                            const float cc[8] = {t0[0], t0[2], t1[0], t1[2], t2[0], t2[2], t3[0], t3[2]};
                            const float ss[8] = {t0[1], t0[3], t1[1], t1[3], t2[1], t2[3], t3[1], t3[3]};
#pragma unroll
                            for (int i = 0; i < 8; ++i) {
                                const float o = __shfl_xor(v[i], 16);
                                const float r0 = v[i] * cc[i] - o * ss[i], r1 = v[i] * cc[i] + o * ss[i];
                                v[i] = (fq == 0) ? r0 : ((fq == 1) ? r1 : v[i]);
                            }
                        }
                    }
                    if (SEG == 0 || SEG == 3) {
                        const int cc = c0 - (SEG == 0 ? 0 : 1536);
#pragma unroll
                        for (int i = 0; i < 8; ++i) v[i] = silu_f(v[i]);
                        u32x4 o = {pk2(v[0], v[1]), pk2(v[2], v[3]), pk2(v[4], v[5]), pk2(v[6], v[7])};
                        *(u32x4*)(ws + (SEG == 0 ? WS_QA : WS_GA) + ((size_t)row * 512 + cc) * 2) = o;
                    } else if (SEG == 1) {
                        const int cc = c0 - 512;
                        const f32x4 lba = *(const f32x4*)(lbl + cc), lbb = *(const f32x4*)(lbl + cc + 4);
                        float r[8];
#pragma unroll
                        for (int i = 0; i < 8; ++i) {
                            const float lb = i < 4 ? lba[i & 3] : lbb[i & 3];
                            const float sg = 1.f / (1.f + __expf(-v[i]));
                            r[i] = __logf(lb + (1.f - lb) * sg);
                        }
                        float* dst = (float*)(ws + WS_LFA) + (size_t)row * 512 + cc;
                        *(f32x4*)dst = (f32x4){r[0], r[1], r[2], r[3]}; *(f32x4*)(dst + 4) = (f32x4){r[4], r[5], r[6], r[7]};
                    } else if (SEG == 2) {
                        const int cc = c0 - 1024;
                        u32x4 o = {pk2(v[0], v[1]), pk2(v[2], v[3]), pk2(v[4], v[5]), pk2(v[6], v[7])};
                        *(u32x4*)(ws + WS_VA + ((size_t)row * 512 + cc) * 2) = o;
                    } else if (SEG == 4) {
                        const int cc = c0 - 2048;
                        const float qs = 0.18033688011112042f;
                        u32x4 o = {pk2(v[0] * qs, v[1] * qs), pk2(v[2] * qs, v[3] * qs), pk2(v[4] * qs, v[5] * qs), pk2(v[6] * qs, v[7] * qs)};
                        *(u32x4*)(ws + WS_QB + ((size_t)row * 512 + cc) * 2) = o;
                    } else if (SEG == 7) {
                        const int cc = c0 - 3072;
                        u32x4 o = {pk2(v[0], v[1]), pk2(v[2], v[3]), pk2(v[4], v[5]), pk2(v[6], v[7])};
                        *(u32x4*)(ws + WS_QI + ((size_t)row * 512 + cc) * 2) = o;
                    } else if (SEG == 5) {
                        const int cc = c0 - 2560;
                        float* dst = row < MP ? out + OFF_KP + (size_t)row * 256 + cc : out + OFF_KS + (size_t)(row - MP) * 256 + cc;
                        *(f32x4*)dst = (f32x4){v[0], v[1], v[2], v[3]}; *(f32x4*)(dst + 4) = (f32x4){v[4], v[5], v[6], v[7]};
                        u32x4 o = {pk2(v[0], v[1]), pk2(v[2], v[3]), pk2(v[4], v[5]), pk2(v[6], v[7])};
                        size_t kr = row < MP ? (size_t)row : (size_t)((row - MP) >> 6) * TKS + TP + ((row - MP) & 63);
                        *(u32x4*)(ws + (row < MP ? WS_KBP : WS_KBS) + (kr * 256 + cc) * 2) = o;
                    } else if (SEG == 6) {
                        const int cc = c0 - 2816;
                        float* dst = row < MP ? out + OFF_VP + (size_t)row * 256 + cc : out + OFF_VS + (size_t)(row - MP) * 256 + cc;
                        *(f32x4*)dst = (f32x4){v[0], v[1], v[2], v[3]}; *(f32x4*)(dst + 4) = (f32x4){v[4], v[5], v[6], v[7]};
                        if (row < MP) {
                            const int b = row >> 11, t = row & 2047;
                            bf16_t* vt = (bf16_t*)(ws + WS_VTP) + ((size_t)b * 256 + cc) * TP + t;
#pragma unroll
                            for (int i = 0; i < 8; ++i) vt[(size_t)i * TP] = f2bf(v[i]);
                        } else {
                            const int b = (row - MP) >> 6, t = TP + ((row - MP) & 63);
                            bf16_t* vt = (bf16_t*)(ws + WS_VTS) + ((size_t)b * 256 + cc) * TKS + t;
#pragma unroll
                            for (int i = 0; i < 8; ++i) vt[(size_t)i * TKS] = f2bf(v[i]);
                        }
                    } else if (SEG == 8) {
                        if (bj == 0) {
                            const int cc = wc * 32 + 8 * fq;
                            if (wc < 2) {
                                float* dst = row < MP ? out + OFF_KIP + (size_t)row * 64 + cc : out + OFF_KIS + (size_t)(row - MP) * 64 + cc;
                                *(f32x4*)dst = (f32x4){v[0], v[1], v[2], v[3]}; *(f32x4*)(dst + 4) = (f32x4){v[4], v[5], v[6], v[7]};
                                u32x4 o = {pk2(v[0], v[1]), pk2(v[2], v[3]), pk2(v[4], v[5]), pk2(v[6], v[7])};
                                size_t kr = row < MP ? (size_t)row : (size_t)((row - MP) >> 6) * TKS + TP + ((row - MP) & 63);
                                *(u32x4*)(ws + (row < MP ? WS_KIP : WS_KIS) + (kr * 64 + cc) * 2) = o;
                            } else if (wc == 2 && fq == 0) {
                                const float sc = 0.044194173824159216f;
                                float* dst = (float*)(ws + WS_WI) + (size_t)row * 8;
                                *(f32x4*)dst = (f32x4){v[0] * sc, v[1] * sc, v[2] * sc, v[3] * sc}; *(f32x4*)(dst + 4) = (f32x4){v[4] * sc, v[5] * sc, v[6] * sc, v[7] * sc};
                            }
                        }
                    }
                }
            }
    }
    __device__ __forceinline__ void operator()(const f32x4 (&acc)[2][2][4][2], const pg8::Unit& u, int wr, int wc, int fr, int fq) const {
        const int pn = u.pn;
        if (pn < 2) run<0>(acc, u, wr, wc, fr, fq);
        else if (pn < 4) run<1>(acc, u, wr, wc, fr, fq);
        else if (pn < 6) run<2>(acc, u, wr, wc, fr, fq);
        else if (pn < 8) run<3>(acc, u, wr, wc, fr, fq);
        else if (pn < 10) run<4>(acc, u, wr, wc, fr, fq);
        else if (pn == 10) run<5>(acc, u, wr, wc, fr, fq);
        else if (pn == 11) run<6>(acc, u, wr, wc, fr, fq);
        else if (pn < 14) run<7>(acc, u, wr, wc, fr, fq);
        else run<8>(acc, u, wr, wc, fr, fq);
    }
};

template <int MODE> struct EpiRes {
    static constexpr bool PERM = false;
    const float* xp; const float* xs; float* dst; const float* mod; float* part;
    __device__ __forceinline__ void operator()(const f32x4 (&acc)[2][2][4][2], const pg8::Unit& u, int wr, int wc, int fr, int fq) const {
        if (u.split) {
            const int ks = u.k0 / (u.nt * 64);
            float* pb = part + (size_t)(u.tidx * (MODE == 0 ? 4 : 16) + ks) * 65536;
#pragma unroll
            for (int ai = 0; ai < 2; ++ai)
#pragma unroll
                for (int m = 0; m < 4; ++m) {
                    const int rloc = (int)opaque((unsigned)(ai * 128 + wr * 64 + m * 16 + fr));
#pragma unroll
                    for (int bj = 0; bj < 2; ++bj)
#pragma unroll
                        for (int n = 0; n < 2; ++n) *(f32x4*)(pb + rloc * 256 + bj * 128 + wc * 32 + n * 16 + 4 * fq) = acc[ai][bj][m][n];
                }
            return;
        }
#pragma unroll
        for (int ai = 0; ai < 2; ++ai)
#pragma unroll
            for (int m = 0; m < 4; ++m) {
                const int row = (int)opaque((unsigned)(u.pm * 256 + ai * 128 + wr * 64 + m * 16 + fr));
                const float* gate = mod + (size_t)row_seq(row) * 6144 + (MODE == 0 ? 2048 : 5120);
                const float* src = MODE == 0 ? (row < MP ? xp + (size_t)row * D : xs + (size_t)(row - MP) * D) : dst + (size_t)row * D;
                float* drow = dst + (size_t)row * D;
#pragma unroll
                for (int bj = 0; bj < 2; ++bj)
#pragma unroll
                    for (int n = 0; n < 2; ++n) {
                        const int c = u.pn * 256 + bj * 128 + wc * 32 + n * 16 + 4 * fq;
                        const f32x4 g = *(const f32x4*)(gate + c), x = *(const f32x4*)(src + c);
                        *(f32x4*)(drow + c) = x + g * acc[ai][bj][m][n];
                    }
            }
    }
};

struct EpiFF1 {
    static constexpr bool PERM = true;
    bf16_t* U;
    __device__ __forceinline__ void operator()(const f32x4 (&acc)[2][2][4][2], const pg8::Unit& u, int wr, int wc, int fr, int fq) const {
#pragma unroll
        for (int ai = 0; ai < 2; ++ai)
#pragma unroll
            for (int m = 0; m < 4; ++m) {
                const int row = (int)opaque((unsigned)(u.pm * 256 + ai * 128 + wr * 64 + m * 16 + fr));
#pragma unroll
                for (int bj = 0; bj < 2; ++bj) {
                    const int c0 = u.pn * 256 + bj * 128 + wc * 32 + 8 * fq;
                    float v[8];
#pragma unroll
                    for (int i = 0; i < 4; ++i) { v[i] = acc[ai][bj][m][0][i]; v[4 + i] = acc[ai][bj][m][1][i]; }
#pragma unroll
                    for (int i = 0; i < 8; ++i) { const float r = fmaxf(v[i], 0.f); v[i] = r * r; }
                    u32x4 o = {pk2(v[0], v[1]), pk2(v[2], v[3]), pk2(v[4], v[5]), pk2(v[6], v[7])};
                    __builtin_nontemporal_store(o, (u32x4*)(U + (size_t)row * DFF + c0));
                }
            }
    }
};

__device__ __forceinline__ void transpose_tile(int wave, const float* src, int ldin, int ncols_valid, bf16_t* dst, int ldout, int k0, int n0, float* tile) {
    const int t = otid(wave);
    {
        const int c4 = (t & 31) * 4, r = t >> 5;
        const int n = n0 + c4;
        f32x4 v[4];
#pragma unroll
        for (int i = 0; i < 4; ++i) v[i] = (n < ncols_valid) ? *(const f32x4*)(src + (size_t)(k0 + r + 16 * i) * ldin + n) : (f32x4){0.f, 0.f, 0.f, 0.f};
#pragma unroll
        for (int i = 0; i < 4; ++i) {
            float* tr = tile + (r + 16 * i) * 129 + c4;
            tr[0] = v[i][0]; tr[1] = v[i][1]; tr[2] = v[i][2]; tr[3] = v[i][3];
        }
    }
    __syncthreads();
#pragma unroll
    for (int h = 0; h < 2; ++h) {
        const int id = t + 512 * h, ko = id & 7, n = id >> 3;
        const float* tc = tile + (ko * 8) * 129 + n;
        const u32x4 o = {pk2(tc[0], tc[129]), pk2(tc[2 * 129], tc[3 * 129]), pk2(tc[4 * 129], tc[5 * 129]), pk2(tc[6 * 129], tc[7 * 129])};
        *(u32x4*)(dst + (size_t)(n0 + n) * ldout + k0 + ko * 8) = o;
    }
    __syncthreads();
}

__device__ __forceinline__ void mod_item(const Params& p, int it, float* smem) {
    float* sc = smem;
    float* red = smem + 16384;
    const int tid = otid(p.wave);
    for (int idx = tid; idx < 16384; idx += NTHREADS) {
        const int s = idx & 15, k = idx >> 4;
        const float c = s < 8 ? p.in[6][s * 1024 + k] : p.in[7][(s - 8) * 1024 + k];
        sc[idx] = silu_f(c);
    }
    __syncthreads();
    const int cl = tid & 63, kg = tid >> 6, col = it * 64 + cl;
    float acc[16];
#pragma unroll
    for (int s = 0; s < 16; ++s) acc[s] = 0.f;
    const float* wm = p.in[8];
#pragma unroll 16
    for (int kk = 0; kk < 128; ++kk) {
        const int k = kg * 128 + kk;
        const float w = wm[(size_t)k * 6144 + col];
        const f32x4* sv = (const f32x4*)(sc + k * 16);
#pragma unroll
        for (int q = 0; q < 4; ++q) { const f32x4 s4 = sv[q]; acc[q * 4 + 0] += w * s4[0]; acc[q * 4 + 1] += w * s4[1]; acc[q * 4 + 2] += w * s4[2]; acc[q * 4 + 3] += w * s4[3]; }
    }
#pragma unroll
    for (int s = 0; s < 16; ++s) red[(kg * 16 + s) * 64 + cl] = acc[s];
    __syncthreads();
    float* mod = (float*)(p.ws + WS_MOD);
    for (int idx = tid; idx < 1024; idx += NTHREADS) {
        const int s = idx >> 6, c = idx & 63;
        float sum = p.in[9][it * 64 + c];
#pragma unroll
        for (int g = 0; g < 8; ++g) sum += red[(g * 16 + s) * 64 + c];
        mod[(size_t)s * 6144 + it * 64 + c] = sum;
    }
    __syncthreads();
}

__device__ __forceinline__ void sincos_acc(float ang, float& c, float& s) {
    const double a = (double)ang;
    const double q = rint(a * 0.63661977236758134308);
    double r = a - q * 1.5707963267948966192;
    r -= q * 6.123233995736766036e-17;
    const double r2 = r * r;
    double sp = r * (1.0 + r2 * (-1.0 / 6 + r2 * (1.0 / 120 + r2 * (-1.0 / 5040 + r2 * (1.0 / 362880 + r2 * (-1.0 / 39916800 + r2 * (1.0 / 6227020800.0)))))));
    double cp = 1.0 + r2 * (-0.5 + r2 * (1.0 / 24 + r2 * (-1.0 / 720 + r2 * (1.0 / 40320 + r2 * (-1.0 / 3628800 + r2 * (1.0 / 479001600.0 + r2 * (-1.0 / 87178291200.0)))))));
    const int qi = ((int)(long long)q) & 3;
    double cc = (qi == 0) ? cp : (qi == 1) ? -sp : (qi == 2) ? -cp : sp;
    double ss = (qi == 0) ? sp : (qi == 1) ? cp : (qi == 2) ? -sp : -cp;
    c = (float)cc; s = (float)ss;
}

__device__ __forceinline__ void phase0(const Params& p, float* smem) {
    const int tid = otid(p.wave);
    constexpr int N_MOD = 96, N_WIN = 480, N_WOUT = 128, N_F1 = 512, N_F2 = 512, N_CV = 512, N_CK = 256, N_CKI = 64, N_ROPE = 33;
    constexpr int TOTAL = N_MOD + N_WIN + N_WOUT + N_F1 + N_F2 + N_CV + N_CK + N_CKI + N_ROPE;
    if (blockIdx.x == 0 && tid == 0) *(int*)(p.ws + WS_QUEUE) = 0;
    int* counter = (int*)(p.ws + WS_QUEUE) + 16;
    volatile int* slot = (volatile int*)((unsigned char*)smem + LDS_BYTES - 16);
    int nxt_item = 0;
    if (tid == 0) nxt_item = atomicAdd(counter, 1);
    for (;;) {
        if (tid == 0) *slot = nxt_item;
        __syncthreads();
        const int item = *slot;
        __syncthreads();
        if (item >= TOTAL) break;
        if (tid == 0) nxt_item = atomicAdd(counter, 1);
        int it = item;
        if (it < N_MOD) { mod_item(p, it, smem); continue; }
        it -= N_MOD;
        if (it < N_WIN) { transpose_tile(p.wave, p.in[11], NIN, NIN, (bf16_t*)(p.ws + WS_WTIN), D, (it / 30) * 64, (it % 30) * 128, smem); continue; }
        it -= N_WIN;
        if (it < N_WOUT) { transpose_tile(p.wave, p.in[14], D, D, (bf16_t*)(p.ws + WS_WTOUT), D, (it / 8) * 64, (it % 8) * 128, smem); continue; }
        it -= N_WOUT;
        if (it < N_F1) { transpose_tile(p.wave, p.in[16], DFF, DFF, (bf16_t*)(p.ws + WS_WTF1), D, (it / 32) * 64, (it % 32) * 128, smem); continue; }
        it -= N_F1;
        if (it < N_F2) { transpose_tile(p.wave, p.in[17], D, D, (bf16_t*)(p.ws + WS_WTF2), DFF, (it / 8) * 64, (it % 8) * 128, smem); continue; }
        it -= N_F2;
        if (it < N_CV) { const int b = it >> 6, r = it & 63; transpose_tile(p.wave, p.in[3] + (size_t)b * TP * 256, 256, 256, (bf16_t*)(p.ws + WS_VTS) + (size_t)b * 256 * TKS, TKS, (r >> 1) * 64, (r & 1) * 128, smem); continue; }
        it -= N_CV;
        if (it < N_CK) {
#pragma unroll
            for (int rep = 0; rep < 4; ++rep) {
                const size_t e = ((size_t)it * 4 + rep) * 4096 + tid * 8; const int b = (int)(e / ((size_t)TP * 256)); const size_t rem = e % ((size_t)TP * 256);
                const f32x4 a = *(const f32x4*)(p.in[2] + e), c = *(const f32x4*)(p.in[2] + e + 4);
                u32x4 o = {pk2(a[0], a[1]), pk2(a[2], a[3]), pk2(c[0], c[1]), pk2(c[2], c[3])};
                *(u32x4*)(p.ws + WS_KBS + ((size_t)b * TKS * 256 + rem) * 2) = o;
            }
            continue;
        }
        it -= N_CK;
        if (it < N_CKI) {
#pragma unroll
            for (int rep = 0; rep < 4; ++rep) {
                const size_t e = ((size_t)it * 4 + rep) * 4096 + tid * 8; const int b = (int)(e / ((size_t)TP * 64)); const size_t rem = e % ((size_t)TP * 64);
                const f32x4 a = *(const f32x4*)(p.in[4] + e), c = *(const f32x4*)(p.in[4] + e + 4);
                u32x4 o = {pk2(a[0], a[1]), pk2(a[2], a[3]), pk2(c[0], c[1]), pk2(c[2], c[3])};
                *(u32x4*)(p.ws + WS_KIS + ((size_t)b * TKS * 64 + rem) * 2) = o;
            }
            continue;
        }
        it -= N_CKI;
        {
            if (it == 0) { const float l0 = p.in[12][tid], l1 = p.in[12][512 + tid]; ((float*)(p.ws + WS_LB))[tid] = 1.f / (1.f + expf(l1 - l0)); }
            const int e = it * 512 + tid;
            if (e < TKS * 8) {
                const int pos = e >> 3, i = e & 7;
                const float inv = (float)exp(-(double)i * 0.125 * 13.122363377404328);
                const float ang = (float)pos * inv;
                float c, s; sincos_acc(ang, c, s);
                float* rope = (float*)(p.ws + WS_ROPE);
                rope[(size_t)pos * 16 + 2 * i] = c; rope[(size_t)pos * 16 + 2 * i + 1] = s;
            }
        }
    }
}

template <int MODE> __device__ __forceinline__ void norm_phase(const Params& p) {
    const int tn = otid(p.wave); const int lane = tn & 63, wv = tn >> 6;
    const float* mod = (const float*)(p.ws + WS_MOD);
    const float* nw = MODE == 0 ? p.in[10] : (MODE == 1 ? p.in[15] : p.in[18]);
    f32x4 w4[4];
#pragma unroll
    for (int j = 0; j < 4; ++j) w4[j] = *(const f32x4*)(nw + lane * 4 + 256 * j);
    for (int row = blockIdx.x * 8 + wv; row < MT; row += gridDim.x * 8) {
        const float* src = MODE == 0 ? (row < MP ? p.in[0] + (size_t)row * D : p.in[1] + (size_t)(row - MP) * D) : p.out + OFF_Y + (size_t)row * D;
        f32x4 v[4]; float s = 0.f;
#pragma unroll
        for (int j = 0; j < 4; ++j) v[j] = *(const f32x4*)(src + lane * 4 + 256 * j);
        if (MODE != 0 && p.ksplit > 1) {
            const int pm4 = (row >> 8) * 4;
            const float* part = (const float*)(p.ws + (MODE == 1 ? WS_R : WS_H));
            const float* gate = mod + (size_t)row_seq(row) * 6144 + (MODE == 1 ? 2048 : 5120);
#pragma unroll
            for (int j = 0; j < 4; ++j) {
                int hit = -1;
#pragma unroll
                for (int t = 0; t < 8; ++t) hit = (t < p.ntail && p.tail[t] == pm4 + j) ? t : hit;
                if (hit >= 0) {
                    constexpr int NSL = MODE == 1 ? 4 : 16;
                    const float* pp = part + (size_t)hit * NSL * 65536 + (row & 255) * 256 + lane * 4;
                    f32x4 sum = (*(const f32x4*)pp + *(const f32x4*)(pp + 65536)) + (*(const f32x4*)(pp + 2 * 65536) + *(const f32x4*)(pp + 3 * 65536));
#pragma unroll
                    for (int sl = 4; sl < NSL; sl += 4)
                        sum = sum + ((*(const f32x4*)(pp + (size_t)sl * 65536) + *(const f32x4*)(pp + (size_t)(sl + 1) * 65536)) + (*(const f32x4*)(pp + (size_t)(sl + 2) * 65536) + *(const f32x4*)(pp + (size_t)(sl + 3) * 65536)));
                    const f32x4 g = *(const f32x4*)(gate + lane * 4 + 256 * j);
                    if (MODE == 1) {
                        const float* xrow = row < MP ? p.in[0] + (size_t)row * D : p.in[1] + (size_t)(row - MP) * D;
                        v[j] = *(const f32x4*)(xrow + lane * 4 + 256 * j) + g * sum;
                        *(f32x4*)(p.out + OFF_Y + (size_t)row * D + lane * 4 + 256 * j) = v[j];
                    } else v[j] = v[j] + g * sum;
                }
            }
        }
#pragma unroll
        for (int j = 0; j < 4; ++j) s += v[j][0] * v[j][0] + v[j][1] * v[j][1] + v[j][2] * v[j][2] + v[j][3] * v[j][3];
        s = wave_sum(s);
        const float rstd = rsqrtf(s * (1.f / D) + 1e-6f);
        if (MODE == 2) {
            float* dst = p.out + OFF_Y + (size_t)row * D;
#pragma unroll
            for (int j = 0; j < 4; ++j) __builtin_nontemporal_store(v[j] * rstd * w4[j], (f32x4*)(dst + lane * 4 + 256 * j));
        } else {
            const float* mrow = mod + (size_t)row_seq(row) * 6144 + (MODE == 0 ? 0 : 3072);
            bf16_t* dst = (bf16_t*)(p.ws + WS_H) + (size_t)row * D;
#pragma unroll
            for (int j = 0; j < 4; ++j) {
                const f32x4 sh = *(const f32x4*)(mrow + lane * 4 + 256 * j), sc = *(const f32x4*)(mrow + 1024 + lane * 4 + 256 * j);
                const f32x4 r = v[j] * rstd * w4[j] * (sc + 1.f) + sh;
                u32x2 o = {pk2(r[0], r[1]), pk2(r[2], r[3])};
                *(u32x2*)(dst + lane * 4 + 256 * j) = o;
            }
        }
    }
}

constexpr int HG_LF = 0;
constexpr int HG_TOT = HG_LF + 64 * 128 * 4;
constexpr int HG_BREL = HG_TOT + 4 * 128 * 4;
constexpr int HG_QE = HG_BREL + 4 * 128 * 4;
constexpr int HG_KE = HG_QE + 64 * 272;
constexpr int HG_KET = HG_KE + 64 * 272;
constexpr int HG_VT = HG_KET + 128 * 144;
constexpr int HG_ST = HG_VT + 128 * 144;
constexpr int HG_PP = HG_ST + 128 * 272;
constexpr int HG_SSQ = HG_PP + 64 * 144;
constexpr int HG_RS = HG_SSQ + 8 * 64 * 4;
constexpr int HG_ER = HG_RS + 64 * 4;
constexpr int HG_EBR = HG_ER + 128 * 4;
constexpr int HG_END = HG_EBR + 128 * 4;
static_assert(HG_END <= LDS_BYTES, "hgrn LDS");

__device__ __forceinline__ void hgrn_unit(const Params& p, unsigned char* smem, int grp, int b, int hh) {
    const int tid = otid(p.wave), lane = tid & 63, w = tid >> 6, l15 = lane & 15, lg = lane >> 4;
    const int nch = grp == 0 ? TP / 64 : 1;
    const int row0 = grp == 0 ? b * TP : MP + b * TS;
    float* LF = (float*)(smem + HG_LF); float* TOT = (float*)(smem + HG_TOT); float* BREL = (float*)(smem + HG_BREL); float* SSQ = (float*)(smem + HG_SSQ);
    float* RS = (float*)(smem + HG_RS); float* ER = (float*)(smem + HG_ER); float* EBR = (float*)(smem + HG_EBR);
    const bf16_t* qA = (const bf16_t*)(p.ws + WS_QA); const float* lfA = (const float*)(p.ws + WS_LFA);
    const bf16_t* vA = (const bf16_t*)(p.ws + WS_VA); const bf16_t* gA = (const bf16_t*)(p.ws + WS_GA);
    bf16_t* mix = (bf16_t*)(p.ws + WS_H);
    f32x4 Sacc[8];
    if (grp == 0) {
#pragma unroll
        for (int kt = 0; kt < 8; ++kt) Sacc[kt] = (f32x4){0.f, 0.f, 0.f, 0.f};
    } else {
        const float* s0 = p.in[5] + ((size_t)(b * 4 + hh) * 128) * 128;
#pragma unroll
        for (int kt = 0; kt < 8; ++kt)
#pragma unroll
            for (int j = 0; j < 4; ++j) Sacc[kt][j] = s0[(size_t)(kt * 16 + lg * 4 + j) * 128 + 16 * w + l15];
    }
    const int t0 = tid >> 4, oc = tid & 15;
    const int kc = tid & 127, part = tid >> 7;
    f32x4 nlf[2][2]; u32x4 nq[2], nv[2], ng[2];
    {
#pragma unroll
        for (int h = 0; h < 2; ++h) {
            const unsigned eo = (unsigned)((row0 + t0 + 32 * h) * 512 + hh * 128 + oc * 8);
            nlf[h][0] = ldg32<f32x4>(lfA, eo * 4u); nlf[h][1] = ldg32<f32x4>(lfA, eo * 4u + 16u);
            nq[h] = ldg32<u32x4>(qA, eo * 2u); nv[h] = ldg32<u32x4>(vA, eo * 2u); ng[h] = ldg32<u32x4>(gA, eo * 2u);
        }
    }
    for (int c = 0; c < nch; ++c) {
        const int tok0 = row0 + c * 64;
        f32x4 clf[2][2]; u32x4 cq[2], cg[2];
#pragma unroll
        for (int h = 0; h < 2; ++h) {
            const int t = t0 + 32 * h;
            const int tsw = (((t >> 3) ^ (oc & 7)) << 4) + (t & 7) * 2;
            clf[h][0] = nlf[h][0]; clf[h][1] = nlf[h][1]; cq[h] = nq[h]; cg[h] = ng[h];
            *(f32x4*)(LF + t * 128 + oc * 8) = clf[h][0]; *(f32x4*)(LF + t * 128 + oc * 8 + 4) = clf[h][1];
#pragma unroll
            for (int i = 0; i < 4; ++i) {
                *(bf16_t*)(smem + HG_VT + (oc * 8 + 2 * i) * 144 + tsw) = (bf16_t)(nv[h][i] & 0xffffu);
                *(bf16_t*)(smem + HG_VT + (oc * 8 + 2 * i + 1) * 144 + tsw) = (bf16_t)(nv[h][i] >> 16);
            }
        }
        if (c + 1 < nch) {
#pragma unroll
            for (int h = 0; h < 2; ++h) {
                const unsigned eo = (unsigned)((tok0 + 64 + t0 + 32 * h) * 512 + hh * 128 + oc * 8);
                nlf[h][0] = ldg32<f32x4>(lfA, eo * 4u); nlf[h][1] = ldg32<f32x4>(lfA, eo * 4u + 16u);
                nq[h] = ldg32<u32x4>(qA, eo * 2u); nv[h] = ldg32<u32x4>(vA, eo * 2u); ng[h] = ldg32<u32x4>(gA, eo * 2u);
            }
        }
        __syncthreads();
        {
            float run = 0.f;
#pragma unroll
            for (int i = 0; i < 16; ++i) { const int t = part * 16 + i; run += LF[t * 128 + kc]; LF[t * 128 + kc] = run; }
            TOT[part * 128 + kc] = run;
        }
        __syncthreads();
        if (tid < 128) {
            const float t0s = TOT[tid], t1s = TOT[128 + tid], t2s = TOT[256 + tid], t3s = TOT[384 + tid];
            const float r = LF[31 * 128 + tid] + t0s;
            const float bl = t0s + t1s + t2s + t3s;
            ER[tid] = __expf(r); EBR[tid] = __expf(bl - r);
            BREL[tid] = -r; BREL[128 + tid] = t0s - r; BREL[256 + tid] = t0s + t1s - r; BREL[384 + tid] = t0s + t1s + t2s - r;
        }
        __syncthreads();
#pragma unroll
        for (int h = 0; h < 2; ++h) {
            const int t = t0 + 32 * h, pt = t >> 4;
            const int tsw = (((t >> 3) ^ (oc & 7)) << 4) + (t & 7) * 2;
            const f32x4 b0 = *(const f32x4*)(LF + t * 128 + oc * 8), b1 = *(const f32x4*)(LF + t * 128 + oc * 8 + 4);
            const f32x4 r0 = *(const f32x4*)(BREL + pt * 128 + oc * 8), r1 = *(const f32x4*)(BREL + pt * 128 + oc * 8 + 4);
            float qe[8], ke[8];
#pragma unroll
            for (int i = 0; i < 8; ++i) {
                const float bmr = (i < 4 ? b0[i & 3] : b1[i & 3]) + (i < 4 ? r0[i & 3] : r1[i & 3]);
                const float lfr = i < 4 ? clf[h][0][i & 3] : clf[h][1][i & 3];
                const unsigned qw = cq[h][i >> 1];
                const float q = __uint_as_float((i & 1) ? (qw & 0xffff0000u) : (qw << 16));
                qe[i] = q * __expf(bmr);
                ke[i] = (1.f - __expf(lfr)) * __expf(-bmr);
            }
            const u32x4 qp = {pk2(qe[0], qe[1]), pk2(qe[2], qe[3]), pk2(qe[4], qe[5]), pk2(qe[6], qe[7])};
            const u32x4 kp = {pk2(ke[0], ke[1]), pk2(ke[2], ke[3]), pk2(ke[4], ke[5]), pk2(ke[6], ke[7])};
            *(u32x4*)(smem + HG_QE + t * 272 + oc * 16) = qp;
            *(u32x4*)(smem + HG_KE + t * 272 + oc * 16) = kp;
#pragma unroll
            for (int i = 0; i < 4; ++i) {
                *(bf16_t*)(smem + HG_KET + (oc * 8 + 2 * i) * 144 + tsw) = (bf16_t)(kp[i] & 0xffffu);
                *(bf16_t*)(smem + HG_KET + (oc * 8 + 2 * i + 1) * 144 + tsw) = (bf16_t)(kp[i] >> 16);
            }
        }
#pragma unroll
        for (int kt = 0; kt < 8; ++kt) {
            const f32x4 er = *(const f32x4*)(ER + kt * 16 + lg * 4);
            Sacc[kt] = Sacc[kt] * er;
            u32x2 o = {pk2(Sacc[kt][0], Sacc[kt][1]), pk2(Sacc[kt][2], Sacc[kt][3])};
            *(u32x2*)(smem + HG_ST + (16 * w + l15) * 272 + (kt * 16 + lg * 4) * 2) = o;
        }
        __syncthreads();
#pragma unroll
        for (int e = 0; e < 2; ++e) {
            const int tile = 2 * w + e, ti = tile >> 2, si = tile & 3;
            f32x4 a = (f32x4){0.f, 0.f, 0.f, 0.f};
            if (si <= ti) {
#pragma unroll
                for (int kk = 0; kk < 4; ++kk) {
                    const bf16x8 af = *(const bf16x8*)(smem + HG_QE + (ti * 16 + l15) * 272 + (kk * 32 + lg * 8) * 2);
                    const bf16x8 bfr = *(const bf16x8*)(smem + HG_KE + (si * 16 + l15) * 272 + (kk * 32 + lg * 8) * 2);
                    a = mfma16(af, bfr, a);
                }
            }
#pragma unroll
            for (int j = 0; j < 4; ++j) {
                const int t = ti * 16 + lg * 4 + j, s = si * 16 + l15;
                const float val = (s <= t && si <= ti) ? a[j] : 0.f;
                *(bf16_t*)(smem + HG_PP + t * 144 + s * 2) = f2bf(val);
            }
        }
        __syncthreads();
        f32x4 oacc[4];
        {
            bf16x8 vf[2];
#pragma unroll
            for (int kk = 0; kk < 2; ++kk) vf[kk] = *(const bf16x8*)(smem + HG_VT + (16 * w + l15) * 144 + (((kk * 4 + lg) ^ (((16 * w + l15) >> 3) & 7)) << 4));
#pragma unroll
            for (int tt = 0; tt < 4; ++tt) {
                f32x4 a = (f32x4){0.f, 0.f, 0.f, 0.f};
#pragma unroll
                for (int kk = 0; kk < 2; ++kk) {
                    const bf16x8 pf = *(const bf16x8*)(smem + HG_PP + (tt * 16 + l15) * 144 + (kk * 32 + lg * 8) * 2);
                    a = mfma16(pf, vf[kk], a);
                }
#pragma unroll
                for (int kk = 0; kk < 4; ++kk) {
                    const bf16x8 qf = *(const bf16x8*)(smem + HG_QE + (tt * 16 + l15) * 272 + (kk * 32 + lg * 8) * 2);
                    const bf16x8 sf = *(const bf16x8*)(smem + HG_ST + (16 * w + l15) * 272 + (kk * 32 + lg * 8) * 2);
                    a = mfma16(qf, sf, a);
                }
                oacc[tt] = a;
            }
#pragma unroll
            for (int kt = 0; kt < 8; ++kt) {
#pragma unroll
                for (int kk = 0; kk < 2; ++kk) {
                    const bf16x8 kf = *(const bf16x8*)(smem + HG_KET + (kt * 16 + l15) * 144 + (((kk * 4 + lg) ^ (((kt * 16 + l15) >> 3) & 7)) << 4));
                    Sacc[kt] = mfma16(kf, vf[kk], Sacc[kt]);
                }
                const f32x4 ebr = *(const f32x4*)(EBR + kt * 16 + lg * 4);
                Sacc[kt] = Sacc[kt] * ebr;
            }
#pragma unroll
            for (int tt = 0; tt < 4; ++tt)
#pragma unroll
                for (int j = 0; j < 4; ++j) {
                    float s = oacc[tt][j] * oacc[tt][j];
                    s += __shfl_xor(s, 1); s += __shfl_xor(s, 2); s += __shfl_xor(s, 4); s += __shfl_xor(s, 8);
                    if (l15 == 0) SSQ[w * 64 + tt * 16 + lg * 4 + j] = s;
                }
        }
        __syncthreads();
        if (tid < 64) {
            float ss = 0.f;
#pragma unroll
            for (int ww = 0; ww < 8; ++ww) ss += SSQ[ww * 64 + tid];
            RS[tid] = rsqrtf(ss * (1.f / 128.f) + 1e-6f);
        }
        __syncthreads();
        {
            const float gn = p.in[13][hh * 128 + 16 * w + l15];
#pragma unroll
            for (int tt = 0; tt < 4; ++tt) {
                const f32x4 rs = *(const f32x4*)(RS + tt * 16 + lg * 4);
#pragma unroll
                for (int j = 0; j < 4; ++j)
                    *(bf16_t*)(smem + HG_QE + (tt * 16 + lg * 4 + j) * 272 + (16 * w + l15) * 2) = f2bf(oacc[tt][j] * rs[j] * gn);
            }
        }
        __syncthreads();
#pragma unroll
        for (int h = 0; h < 2; ++h) {
            const int t = t0 + 32 * h;
            const int tsw = (((t >> 3) ^ (oc & 7)) << 4) + (t & 7) * 2;
            const u32x4 ov = *(const u32x4*)(smem + HG_QE + t * 272 + oc * 16);
            u32x4 res;
#pragma unroll
            for (int i = 0; i < 4; ++i) {
                const float o0 = __uint_as_float(ov[i] << 16) * __uint_as_float(cg[h][i] << 16);
                const float o1 = __uint_as_float(ov[i] & 0xffff0000u) * __uint_as_float(cg[h][i] & 0xffff0000u);
                res[i] = pk2(o0, o1);
            }
            stgp<u32x4>((char*)mix + ((size_t)(tok0 + t) * D + hh * 128 + oc * 8) * 2, res);
        }
    }
    float* so = p.out + (grp == 0 ? OFF_HP : OFF_HS) + ((size_t)(b * 4 + hh) * 128) * 128;
#pragma unroll
    for (int kt = 0; kt < 8; ++kt)
#pragma unroll
        for (int j = 0; j < 4; ++j) so[(size_t)(kt * 16 + lg * 4 + j) * 128 + 16 * w + l15] = Sacc[kt][j];
    __syncthreads();
}

constexpr int DS_CNT = 0;
constexpr int DS_ML = DS_CNT + 2 * 8 * 16 * 4;
constexpr int DS_OW = DS_ML + 8 * 2 * 16 * 8;
constexpr int DS_END = DS_OW + 8 * 2 * 64 * 16 * 4;
constexpr int DS_BM = 0;
constexpr int DS_ML2 = 4352;
constexpr int DS_OW2 = DS_ML2 + 4 * 2 * 16 * 8;
static_assert(DS_END <= LDS_BYTES, "dsa LDS");

__device__ __forceinline__ unsigned sortable(float f) { const unsigned u = __float_as_uint(f); return (u & 0x80000000u) ? ~u : (u | 0x80000000u); }

__device__ __forceinline__ void dsa_item(const Params& p, unsigned char* smem, int grp, int b, int c, int sub) {
    const int tid = otid(p.wave), lane = tid & 63, w = tid >> 6, l15 = lane & 15, lg = lane >> 4;
    const int nk = grp == 0 ? (c + 1) * 64 : TKS;
    const int ntiles = nk >> 4;
    const int ldv = grp == 0 ? TP : TKS;
    const bf16_t* kI = (const bf16_t*)(p.ws + (grp == 0 ? WS_KIP : WS_KIS)) + (size_t)b * ldv * 64;
    const bf16_t* kB = (const bf16_t*)(p.ws + (grp == 0 ? WS_KBP : WS_KBS)) + (size_t)b * ldv * 256;
    const bf16_t* vT = (const bf16_t*)(p.ws + (grp == 0 ? WS_VTP : WS_VTS)) + (size_t)b * 256 * ldv;
    const bf16_t* qI = (const bf16_t*)(p.ws + WS_QI); const bf16_t* qB = (const bf16_t*)(p.ws + WS_QB);
    const float* wI = (const float*)(p.ws + WS_WI);
    bf16_t* mix = (bf16_t*)(p.ws + WS_H);
    int* CNT = (int*)(smem + DS_CNT); float* ML = (float*)(smem + DS_ML); float* OW = (float*)(smem + DS_OW);
    const int qr = (grp == 0 ? b * TP + c * 64 : MP + b * TS) + sub * 16;
    const int nblk = nk >> 5;
    const int krow = 8 * (l15 >> 2) + (l15 & 3);
    const unsigned kIoff = (unsigned)(((w * 32 + krow) * 64 + lg * 8) * 2);
    const unsigned kBoff = (unsigned)(((w * 32 + krow) * 256 + lg * 8) * 2);
    const unsigned vToff = (unsigned)((l15 * ldv + w * 32 + lg * 8) * 2);
    unsigned msk[3] = {0u, 0u, 0u};
    {
        unsigned keys[72];
        {
            bf16x8 bq[8][2]; float wq[8];
#pragma unroll
            for (int h = 0; h < 8; ++h) {
#pragma unroll
                for (int kk = 0; kk < 2; ++kk) bq[h][kk] = ldgp<bf16x8>(qI + (size_t)(qr + l15) * 512 + h * 64 + kk * 32 + lg * 8);
                wq[h] = ldgp<float>(wI + (size_t)(qr + l15) * 8 + h);
            }
            bf16x8 ka[2][2];
#define KI_SLOT_OFF(i) ((unsigned)((i) >> 1) * (8u * 32u * 128u) + (unsigned)((i) & 1) * (4u * 128u))
            if (w < nblk) { const unsigned ko = opaque(kIoff); ka[0][0] = ldg32<bf16x8>(kI, ko); ka[0][1] = ldg32<bf16x8>(kI, ko + 64u); }
            __builtin_amdgcn_sched_barrier(0);
#pragma unroll
            for (int i = 0; i < 18; ++i) {
                if (w + 8 * (i >> 1) < nblk) {
                    if (i + 1 < 18 && (w + 8 * ((i + 1) >> 1) < nblk)) { const unsigned ko = opaque(kIoff) + KI_SLOT_OFF(i + 1); ka[(i + 1) & 1][0] = ldg32<bf16x8>(kI, ko); ka[(i + 1) & 1][1] = ldg32<bf16x8>(kI, ko + 64u); }
                    const bf16x8 a0 = ka[i & 1][0], a1 = ka[i & 1][1];
                    f32x4 sc = (f32x4){0.f, 0.f, 0.f, 0.f};
#pragma unroll
                    for (int h = 0; h < 8; ++h) {
                        f32x4 a = mfma16(a0, bq[h][0], (f32x4){0.f, 0.f, 0.f, 0.f});
                        a = mfma16(a1, bq[h][1], a);
#pragma unroll
                        for (int j = 0; j < 4; ++j) sc[j] += wq[h] * fmaxf(a[j], 0.f);
                    }
#pragma unroll
                    for (int j = 0; j < 4; ++j) keys[i * 4 + j] = sortable(sc[j]);
                } else {
#pragma unroll
                    for (int j = 0; j < 4; ++j) keys[i * 4 + j] = 0u;
                }
                __builtin_amdgcn_sched_barrier(0);
            }
#undef KI_SLOT_OFF
        }
        unsigned thr = 1u;
        if (nk > 256) {
            unsigned* SC = (unsigned*)smem;
            unsigned* THR = (unsigned*)(smem + 16 * 2113 * 4);
#pragma unroll
            for (int i = 0; i < 18; ++i)
                if (w + 8 * (i >> 1) < nblk) {
                    const int kidx = 32 * (w + 8 * (i >> 1)) + 8 * lg + 4 * (i & 1);
#pragma unroll
                    for (int j = 0; j < 4; ++j) SC[l15 * 2113 + kidx + j] = keys[i * 4 + j];
                }
            __syncthreads();
            const int nr = nk >> 6;
#pragma unroll
            for (int qq = 0; qq < 2; ++qq) {
                unsigned myk[33];
#pragma unroll
                for (int r = 0; r < 33; ++r) myk[r] = (r < nr) ? SC[(2 * w + qq) * 2113 + r * 64 + lane] : 0u;
                unsigned t = 0u; int cat = nk;
                for (int bit = 31; bit >= 0; --bit) {
                    const unsigned cand = t | (1u << bit);
                    int cnt = 0;
#pragma unroll
                    for (int r = 0; r < 33; ++r) cnt += (int)__popcll(__ballot(myk[r] >= cand));
                    if (cnt >= 256) { t = cand; cat = cnt; }
                    if (cat == 256) break;
                }
                if (lane == 0) THR[2 * w + qq] = t;
            }
            __syncthreads();
            thr = THR[l15];
        }
#pragma unroll
        for (int i = 0; i < 72; ++i) msk[i >> 5] |= (keys[i] >= thr) ? (1u << (i & 31)) : 0u;
    }
    {
        unsigned char* BM = smem + DS_BM;
#pragma unroll
        for (int ip = 0; ip < 9; ++ip)
            if (w + 8 * ip < nblk) BM[(l15 * 66 + (w + 8 * ip)) * 4 + lg] = (unsigned char)((msk[(8 * ip) >> 5] >> ((8 * ip) & 31)) & 0xffu);
    }
    __syncthreads();
    {
        const int wu = __builtin_amdgcn_readfirstlane(w), n = wu >> 1, half = wu & 1;
        const unsigned char* BM = smem + DS_BM + l15 * 66 * 4 + lg;
        bf16x8 bqB[2][2];
#pragma unroll
        for (int g = 0; g < 2; ++g)
#pragma unroll
            for (int kk = 0; kk < 2; ++kk) bqB[g][kk] = ldgp<bf16x8>(qB + (size_t)(qr + l15) * 512 + (n * 2 + g) * 64 + kk * 32 + lg * 8);
        const unsigned kBc = (unsigned)((krow * 256 + lg * 8) * 2 + n * 128);
        const unsigned vTc = (unsigned)(((n * 64 + l15) * ldv + lg * 8) * 2);
        float mrun[2] = {-1e30f, -1e30f}, lrun[2] = {0.f, 0.f};
        f32x4 O[2][4];
#pragma unroll
        for (int g = 0; g < 2; ++g)
#pragma unroll
            for (int dt = 0; dt < 4; ++dt) O[g][dt] = (f32x4){0.f, 0.f, 0.f, 0.f};
        bf16x8 kf[2][2][2];
        bf16x8 vfb[2][4];
#define DSA_LOAD_BLK(BK, BUF) do { \
            const unsigned _ko = opaque(kBc) + (unsigned)(BK) * (32u * 512u); \
            kf[BUF][0][0] = ldg32<bf16x8>(kB, _ko); kf[BUF][0][1] = ldg32<bf16x8>(kB, _ko + 64u); \
            kf[BUF][1][0] = ldg32<bf16x8>(kB, _ko + 2048u); kf[BUF][1][1] = ldg32<bf16x8>(kB, _ko + 2048u + 64u); \
            _Pragma("unroll") for (int dt = 0; dt < 4; ++dt) vfb[BUF][dt] = ldg32<bf16x8>(vT, opaque(vTc) + (unsigned)(dt * 16 * ldv * 2) + (unsigned)(BK) * 64u); \
        } while (0)
#define DSA_PROCESS(BK, BUF) do { \
            f32x4 lgt[2][2]; \
            _Pragma("unroll") for (int e = 0; e < 2; ++e) _Pragma("unroll") for (int g = 0; g < 2; ++g) { \
                f32x4 a = mfma16(kf[BUF][e][0], bqB[g][0], (f32x4){0.f, 0.f, 0.f, 0.f}); lgt[g][e] = mfma16(kf[BUF][e][1], bqB[g][1], a); } \
            const unsigned sb = BM[(BK) * 4]; \
            _Pragma("unroll") for (int g = 0; g < 2; ++g) { \
                float tmax = -1e30f; \
                _Pragma("unroll") for (int e = 0; e < 2; ++e) _Pragma("unroll") for (int j = 0; j < 4; ++j) tmax = ((sb >> (4 * e + j)) & 1u) ? fmaxf(tmax, lgt[g][e][j]) : tmax; \
                tmax = fmaxf(tmax, __shfl_xor(tmax, 16)); tmax = fmaxf(tmax, __shfl_xor(tmax, 32)); \
                const float mnew = fmaxf(mrun[g], tmax); \
                const float alpha = __builtin_amdgcn_exp2f(mrun[g] - mnew); \
                mrun[g] = mnew; \
                float pv[2][4]; float psum = 0.f; \
                _Pragma("unroll") for (int e = 0; e < 2; ++e) _Pragma("unroll") for (int j = 0; j < 4; ++j) { \
                    pv[e][j] = ((sb >> (4 * e + j)) & 1u) ? __builtin_amdgcn_exp2f(lgt[g][e][j] - mnew) : 0.f; psum += pv[e][j]; } \
                lrun[g] = lrun[g] * alpha + psum; \
                const u32x4 pp = {pk2(pv[0][0], pv[0][1]), pk2(pv[0][2], pv[0][3]), pk2(pv[1][0], pv[1][1]), pk2(pv[1][2], pv[1][3])}; \
                const bf16x8 pf = __builtin_bit_cast(bf16x8, pp); \
                if (!__all(alpha == 1.f)) { _Pragma("unroll") for (int dt = 0; dt < 4; ++dt) O[g][dt] *= alpha; } \
                _Pragma("unroll") for (int dt = 0; dt < 4; ++dt) O[g][dt] = mfma16(vfb[BUF][dt], pf, O[g][dt]); \
            } \
        } while (0)
        const int cnt = (nblk - half + 1) >> 1;
        int Bk = half;
        if (cnt > 0) DSA_LOAD_BLK(Bk, 0);
        for (int it = 0; it < cnt; it += 2) {
            if (it + 1 < cnt) DSA_LOAD_BLK(Bk + 2, 1);
            DSA_PROCESS(Bk, 0);
            if (it + 1 < cnt) {
                if (it + 2 < cnt) DSA_LOAD_BLK(Bk + 4, 0);
                DSA_PROCESS(Bk + 2, 1);
            }
            Bk += 4;
        }
#undef DSA_LOAD_BLK
#undef DSA_PROCESS
        float* ML2 = (float*)(smem + DS_ML2); float* OW2 = (float*)(smem + DS_OW2);
#pragma unroll
        for (int g = 0; g < 2; ++g) { float l = lrun[g]; l += __shfl_xor(l, 16); l += __shfl_xor(l, 32); lrun[g] = l; }
        if (half == 1) {
#pragma unroll
            for (int g = 0; g < 2; ++g) {
                if (lane < 16) { ML2[((n * 2 + g) * 16 + lane) * 2] = mrun[g]; ML2[((n * 2 + g) * 16 + lane) * 2 + 1] = lrun[g]; }
#pragma unroll
                for (int dt = 0; dt < 4; ++dt)
#pragma unroll
                    for (int j = 0; j < 4; ++j) OW2[((n * 2 + g) * 64 + dt * 16 + lg * 4 + j) * 16 + l15] = O[g][dt][j];
            }
        }
        __syncthreads();
        if (half == 0) {
#pragma unroll
            for (int g = 0; g < 2; ++g) {
                const float m2 = ML2[((n * 2 + g) * 16 + l15) * 2], l2 = ML2[((n * 2 + g) * 16 + l15) * 2 + 1];
                const float M = fmaxf(mrun[g], m2);
                const float f1 = __builtin_amdgcn_exp2f(mrun[g] - M), f2 = __builtin_amdgcn_exp2f(m2 - M);
                const float inv = 1.f / (lrun[g] * f1 + l2 * f2);
#pragma unroll
                for (int dt = 0; dt < 4; ++dt) {
                    float o[4];
#pragma unroll
                    for (int j = 0; j < 4; ++j) o[j] = (O[g][dt][j] * f1 + OW2[((n * 2 + g) * 64 + dt * 16 + lg * 4 + j) * 16 + l15] * f2) * inv;
                    const u32x2 ov = {pk2(o[0], o[1]), pk2(o[2], o[3])};
                    stgp<u32x2>(mix + (size_t)(qr + l15) * D + 512 + (n * 2 + g) * 64 + dt * 16 + lg * 4, ov);
                }
            }
        }
    }
}

constexpr int MIX_ITEMS = 64 + 33 * 32;
__device__ __forceinline__ void mixer_phase(const Params& p, unsigned char* smem) {
    int* counter = (int*)(p.ws + WS_QUEUE);
    volatile int* slot = (volatile int*)(smem + LDS_BYTES - 16);
    for (;;) {
        if (threadIdx.x == 0) *slot = atomicAdd(counter, 1);
        __syncthreads();
        const int item = *slot;
        __syncthreads();
        if (item >= MIX_ITEMS) break;
        if (item < 64) {
            hgrn_unit(p, smem, item >> 5, (item & 31) >> 2, item & 3);
        } else {
            const int j = item - 64, rank = j >> 5, bs = j & 31;
            dsa_item(p, smem, rank == 0 ? 1 : 0, bs >> 2, 32 - rank, bs & 3);
        }
        __syncthreads();
    }
}

#define XB_TMO      128
#define XB_XCNT(j)  (256  + 64 * (j))
#define XB_XSUB(j)  (1280 + 64 * (j))
#define XB_XGEN(j)  (2304 + 64 * (j))
#define XB_TOP      3328
#define XB_TOPGEN   3392
#define XCD_BAR_WORDS 3456
#define XB_SPIN_CAP (1u << 18)
__device__ __forceinline__ unsigned xb_ld(unsigned* p)              { return __hip_atomic_load(p, __ATOMIC_RELAXED, __HIP_MEMORY_SCOPE_AGENT); }
__device__ __forceinline__ unsigned xb_add(unsigned* p, unsigned v) { return __hip_atomic_fetch_add(p, v, __ATOMIC_RELAXED, __HIP_MEMORY_SCOPE_AGENT); }
__device__ __forceinline__ unsigned xb_xcc_id() { return (unsigned)__builtin_amdgcn_s_getreg((3 << 11) | 20) & 0xFu; }
#define XB_SPIN(cond, bar) do { unsigned _sp = 0; while (cond) { __builtin_amdgcn_s_sleep(1); \
    if ((++_sp & 255u) == 0u) { if (xb_ld(&(bar)[XB_TMO])) break; if (_sp > XB_SPIN_CAP) { atomicAdd(&(bar)[XB_TMO], 1u); break; } } } } while (0)
struct XcdBarrier { unsigned* bar; unsigned x; volatile LAS unsigned* st; };
__device__ __forceinline__ XcdBarrier xcd_barrier_post(unsigned* bar, volatile LAS unsigned* st) {
    XcdBarrier b; b.bar = bar; b.x = xb_xcc_id(); b.st = st;
    if (threadIdx.x == 0) (void)xb_add(&bar[XB_XCNT(b.x)], 1u);
    return b;
}
__device__ __forceinline__ void xcd_barrier_complete(unsigned* bar, unsigned x, unsigned& nloc, unsigned& nx) {
    const unsigned G = gridDim.x * gridDim.y * gridDim.z;
    unsigned sum, cnt, mine, sp = 0u;
    for (;;) {
        sum = 0u; cnt = 0u; mine = 0u;
#pragma unroll
        for (unsigned j = 0; j < 16; ++j) { const unsigned c = xb_ld(&bar[XB_XCNT(j)]); sum += c; cnt += (c > 0u) ? 1u : 0u; mine = (j == x) ? c : mine; }
        if (sum == G) break;
        __builtin_amdgcn_s_sleep(1);
        if ((++sp & 255u) == 0u) { if (xb_ld(&bar[XB_TMO])) break; if (sp > XB_SPIN_CAP) { atomicAdd(&bar[XB_TMO], 1u); break; } }
    }
    nloc = mine > 0u ? mine : 1u; nx = cnt > 0u ? cnt : 1u;
}
__device__ __forceinline__ void xcd_barrier(const XcdBarrier& b) {
    asm volatile("s_waitcnt vmcnt(0)" ::: "memory");
    __syncthreads();
    if (threadIdx.x == 0) {
        unsigned* bar = b.bar;
        __builtin_amdgcn_s_waitcnt(0);
        unsigned nloc = b.st[0], nx = b.st[1];
        if (nloc == 0u) { xcd_barrier_complete(bar, b.x, nloc, nx); b.st[0] = nloc; b.st[1] = nx; }
        const unsigned old = xb_add(&bar[XB_XSUB(b.x)], 1u);
        const unsigned gen = old / nloc;
        if (old + 1u == (gen + 1u) * nloc) {
            __builtin_amdgcn_fence(__ATOMIC_RELEASE, "agent");
            asm volatile("s_waitcnt vmcnt(0)" ::: "memory");
            const unsigned og = xb_add(&bar[XB_TOP], 1u);
            const unsigned tg = og / nx;
            if (og + 1u == (tg + 1u) * nx) xb_add(&bar[XB_TOPGEN], 1u);
            else XB_SPIN(xb_ld(&bar[XB_TOPGEN]) == tg, bar);
            __builtin_amdgcn_fence(__ATOMIC_ACQUIRE, "agent");
            xb_add(&bar[XB_XGEN(b.x)], 1u);
            asm volatile("s_waitcnt vmcnt(0)" ::: "memory");
        } else {
            XB_SPIN(xb_ld(&bar[XB_XGEN(b.x)]) == gen, bar);
            __builtin_amdgcn_fence(__ATOMIC_ACQUIRE, "agent");
            asm volatile("s_waitcnt vmcnt(0)" ::: "memory");
        }
    }
    __syncthreads();
}

#ifndef ONE_LAUNCH
#define ONE_LAUNCH 1
#endif
template <int PH> __global__ void __launch_bounds__(NTHREADS) fwd_kernel(Params p) {
    extern __shared__ __attribute__((aligned(16))) unsigned char smem[];
    LAS unsigned char* lds = (LAS unsigned char*)smem;
    const int G = (int)gridDim.x, cb = (int)blockIdx.x;
    const int wave_id = __builtin_amdgcn_readfirstlane((int)threadIdx.x >> 6);
    constexpr bool MULTI = (PH & (PH - 1)) != 0;
    volatile LAS unsigned* xst = (volatile LAS unsigned*)(lds + LDS_BYTES - 32);
    if constexpr (MULTI) { if (threadIdx.x == 0) { xst[0] = 0u; xst[1] = 0u; } __syncthreads(); }
    XcdBarrier xb{};
    if constexpr (MULTI) xb = xcd_barrier_post((unsigned*)(p.ws + WS_BAR), xst);
#define GRID_SYNC() do { if constexpr (MULTI) xcd_barrier(xb); } while (0)
#define FRESH(q) Params q = p; q.wave = wave_id; asm volatile("" : "+s"(q.ws), "+s"(q.out))
    if constexpr (PH & 1) { FRESH(q); phase0(q, (float*)smem); }
    GRID_SYNC();
    if constexpr (PH & 2) { FRESH(q); norm_phase<0>(q); }
    GRID_SYNC();
    if constexpr (PH & 4) {
        FRESH(q);
        pg8::Gemm g{(const bf16_t*)(q.ws + WS_H), (const bf16_t*)(q.ws + WS_WTIN), MT, NINP, D, q.wave};
        pg8::StaticOrder S; S.init(MT, NINP, D, G, cb, 1);
        EpiIn E{q.out, q.ws, (const float*)(q.ws + WS_LB)};
        pg8::gemm_phase(lds, g, S, E);
    }
    GRID_SYNC();
    if constexpr (PH & 8) { FRESH(q); mixer_phase(q, smem); }
    GRID_SYNC();
    if constexpr (PH & 16) {
        FRESH(q);
        pg8::Gemm g{(const bf16_t*)(q.ws + WS_H), (const bf16_t*)(q.ws + WS_WTOUT), MT, D, D, q.wave};
        pg8::StaticOrder S; S.init(MT, D, D, G, cb, q.ksplit);
        EpiRes<0> E{q.in[0], q.in[1], q.out + OFF_Y, (const float*)(q.ws + WS_MOD), (float*)(q.ws + WS_R)};
        pg8::gemm_phase(lds, g, S, E);
    }
    GRID_SYNC();
    if constexpr (PH & 32) { FRESH(q); norm_phase<1>(q); }
    GRID_SYNC();
    if constexpr (PH & 64) {
        FRESH(q);
        pg8::Gemm g{(const bf16_t*)(q.ws + WS_H), (const bf16_t*)(q.ws + WS_WTF1), MT, DFF, D, q.wave};
        pg8::StaticOrder S; S.init(MT, DFF, D, G, cb, 1);
        EpiFF1 E{(bf16_t*)(q.ws + WS_U)};
        pg8::gemm_phase(lds, g, S, E);
    }
    GRID_SYNC();
    if constexpr (PH & 128) {
        FRESH(q);
        pg8::Gemm g{(const bf16_t*)(q.ws + WS_U), (const bf16_t*)(q.ws + WS_WTF2), MT, D, DFF, q.wave};
        pg8::StaticOrder S; S.init(MT, D, DFF, G, cb, q.ksplit > 1 ? 16 : 1);
        EpiRes<1> E{nullptr, nullptr, q.out + OFF_Y, (const float*)(q.ws + WS_MOD), (float*)(q.ws + WS_H)};
        pg8::gemm_phase(lds, g, S, E);
    }
    GRID_SYNC();
    if constexpr (PH & 256) { FRESH(q); norm_phase<2>(q); }
#undef FRESH
#undef GRID_SYNC
}

template <int PH> static bool prep_kernel() {
    return hipFuncSetAttribute((const void*)fwd_kernel<PH>, hipFuncAttributeMaxDynamicSharedMemorySize, LDS_BYTES) == hipSuccess;
}
template <int PH> static void launch_plain(const Params& p, int grid, hipStream_t stream) {
    hipLaunchKernelGGL(fwd_kernel<PH>, dim3(grid), dim3(NTHREADS), LDS_BYTES, stream, p);
}

extern "C" void kernel_launch(void* const* d_in, const int* in_sizes, int n_in, void* d_out, int out_size, void* d_ws, size_t ws_size, hipStream_t stream) {
    static int grid_blocks = 0;
    if (grid_blocks == 0) {
        if (n_in != 19 || ws_size < WS_END) { fprintf(stderr, "kernel_launch: unexpected n_in %d / ws_size %zu (need %zu)\n", n_in, ws_size, (size_t)WS_END); grid_blocks = -1; return; }
        int dev = 0, cus = 0, per_cu = 0;
        (void)hipGetDevice(&dev);
        (void)hipDeviceGetAttribute(&cus, hipDeviceAttributeMultiprocessorCount, dev);
#if ONE_LAUNCH
        if (!prep_kernel<511>()) { fprintf(stderr, "kernel_launch: hipFuncSetAttribute failed\n"); grid_blocks = -1; return; }
        if (hipOccupancyMaxActiveBlocksPerMultiprocessor(&per_cu, (const void*)fwd_kernel<511>, NTHREADS, LDS_BYTES) != hipSuccess || per_cu < 1) { fprintf(stderr, "kernel_launch: occupancy query failed (%d)\n", per_cu); grid_blocks = -1; return; }
        grid_blocks = cus * per_cu;
#else
        bool ok = prep_kernel<1>() && prep_kernel<2>() && prep_kernel<4>() && prep_kernel<8>() && prep_kernel<16>() && prep_kernel<32>() && prep_kernel<64>() && prep_kernel<128>() && prep_kernel<256>();
        if (!ok) { fprintf(stderr, "kernel_launch: hipFuncSetAttribute failed\n"); grid_blocks = -1; return; }
        (void)per_cu;
        grid_blocks = cus;
#endif
    }
    if (grid_blocks < 0) return;
    Params p{};
    for (int i = 0; i < 19; ++i) p.in[i] = (const float*)d_in[i];
    p.out = (float*)d_out; p.ws = (unsigned char*)d_ws;
    {
        const int nM = MT / 256, nN = 4, nwg = nM * nN, G = grid_blocks, nfull = (nwg / G) * G, ntail = nwg - nfull;
        p.ntail = 0; p.ksplit = 1;
        if (ntail > 0 && ntail <= 8) {
            p.ntail = ntail; p.ksplit = 4;
            for (int t = 0; t < ntail; ++t) {
                int wgid = nfull + t;
                { const int q = nwg / 8, r = nwg % 8, xcd = wgid % 8, off = wgid / 8; wgid = (xcd < r ? xcd * (q + 1) : r * (q + 1) + (xcd - r) * q) + off; }
                const int nig = 8 * nN, gid = wgid / nig, fm = gid * 8, gsz = (nM - fm) < 8 ? (nM - fm) : 8;
                const int pm = fm + ((wgid % nig) % gsz), pn = (wgid % nig) / gsz;
                p.tail[t] = pm * 4 + pn;
            }
        }
    }
#if ONE_LAUNCH
    (void)hipMemsetAsync((unsigned char*)d_ws + WS_QUEUE, 0, 256 + 16384, stream);
    void* args[] = {&p};
    hipError_t e = hipLaunchCooperativeKernel((const void*)fwd_kernel<511>, dim3(grid_blocks), dim3(NTHREADS), args, LDS_BYTES, stream);
    if (e != hipSuccess) fprintf(stderr, "cooperative launch failed: %s (grid %d)\n", hipGetErrorString(e), grid_blocks);
#else
    launch_plain<1>(p, grid_blocks, stream);
    launch_plain<2>(p, grid_blocks, stream);
    launch_plain<4>(p, grid_blocks, stream);
    launch_plain<8>(p, grid_blocks, stream);
    launch_plain<16>(p, grid_blocks, stream);
    launch_plain<32>(p, grid_blocks, stream);
    launch_plain<64>(p, grid_blocks, stream);
    launch_plain<128>(p, grid_blocks, stream);
    launch_plain<256>(p, grid_blocks, stream);
#endif
}
```

```cpp
#include <hip/hip_runtime.h>
#include <hip/hip_cooperative_groups.h>
#include <cstdio>
namespace cg = cooperative_groups;

#define LAS __attribute__((address_space(3)))
typedef unsigned short bf16_t;
typedef short bf16x8 __attribute__((ext_vector_type(8)));
typedef float f32x4 __attribute__((ext_vector_type(4)));
typedef unsigned u32x4 __attribute__((ext_vector_type(4)));
typedef unsigned u32x2 __attribute__((ext_vector_type(2)));

constexpr int D = 1024, TP = 2048, TS = 64, TKS = 2112;
constexpr int MP = 16384, MT = 16896;
constexpr int NIN = 3656, NINP = 3840, DFF = 4096;
constexpr int NTHREADS = 512;
constexpr int LDS_BYTES = 163840;

constexpr size_t OFF_Y = 0, OFF_KP = 17301504, OFF_VP = 21495808, OFF_KIP = 25690112, OFF_HP = 26738688,
                 OFF_KS = 27262976, OFF_VS = 27394048, OFF_KIS = 27525120, OFF_HS = 27557888;

constexpr size_t WS_WTIN = 0;
constexpr size_t WS_WTOUT = WS_WTIN + (size_t)NINP * D * 2;
constexpr size_t WS_WTF1 = WS_WTOUT + (size_t)D * D * 2;
constexpr size_t WS_WTF2 = WS_WTF1 + (size_t)DFF * D * 2;
constexpr size_t WS_MOD = WS_WTF2 + (size_t)D * DFF * 2;
constexpr size_t WS_ROPE = WS_MOD + (size_t)16 * 6144 * 4;
constexpr size_t WS_LB = WS_ROPE + (size_t)TKS * 16 * 4;
constexpr size_t WS_QUEUE = WS_LB + 512 * 4;
constexpr size_t WS_BAR = WS_QUEUE + 256;
constexpr size_t WS_H = WS_BAR + 16384;
constexpr size_t WS_R = WS_H + (size_t)MT * D * 2;
constexpr size_t WS_QA = WS_R;
constexpr size_t WS_LFA = WS_QA + (size_t)MT * 512 * 2;
constexpr size_t WS_VA = WS_LFA + (size_t)MT * 512 * 4;
constexpr size_t WS_GA = WS_VA + (size_t)MT * 512 * 2;
constexpr size_t WS_QB = WS_GA + (size_t)MT * 512 * 2;
constexpr size_t WS_QI = WS_QB + (size_t)MT * 512 * 2;
constexpr size_t WS_KBP = WS_QI + (size_t)MT * 512 * 2;
constexpr size_t WS_KBS = WS_KBP + (size_t)8 * TP * 256 * 2;
constexpr size_t WS_VTP = WS_KBS + (size_t)8 * TKS * 256 * 2;
constexpr size_t WS_VTS = WS_VTP + (size_t)8 * 256 * TP * 2;
constexpr size_t WS_KIP = WS_VTS + (size_t)8 * 256 * TKS * 2;
constexpr size_t WS_KIS = WS_KIP + (size_t)8 * TP * 64 * 2;
constexpr size_t WS_WI = WS_KIS + (size_t)8 * TKS * 64 * 2;
constexpr size_t WS_REND = WS_WI + (size_t)MT * 8 * 4;
constexpr size_t WS_U = WS_R;
constexpr size_t WS_UEND = WS_U + (size_t)MT * DFF * 2;
constexpr size_t WS_END = (WS_REND > WS_UEND ? WS_REND : WS_UEND);
static_assert(WS_END <= (size_t)256 * 1024 * 1024, "workspace too large");

struct Params {
    const float* in[19];
    float* out;
    unsigned char* ws;
    int tail[8];
    int ntail, ksplit;
    int wave, pad;
};

typedef float f32x2 __attribute__((ext_vector_type(2)));
typedef __bf16 bf16x2_t __attribute__((ext_vector_type(2)));
__device__ __forceinline__ unsigned pk2(float lo, float hi) { const f32x2 v = {lo, hi}; return __builtin_bit_cast(unsigned, __builtin_convertvector(v, bf16x2_t)); }
__device__ __forceinline__ bf16_t f2bf(float f) { return (bf16_t)(pk2(f, 0.f) & 0xffffu); }
__device__ __forceinline__ float bf2f(bf16_t b) { return __uint_as_float(((unsigned)b) << 16); }
__device__ __forceinline__ float silu_f(float x) { return x / (1.f + __expf(-x)); }
__device__ __forceinline__ float wave_sum(float v) {
#pragma unroll
    for (int o = 32; o >= 1; o >>= 1) v += __shfl_xor(v, o);
    return v;
}
#define GAS __attribute__((address_space(1)))
template <class T> __device__ __forceinline__ T ldg32(const void* base, unsigned off) { return *(const GAS T*)((const GAS char*)base + off); }
template <class T> __device__ __forceinline__ T ldgp(const void* ptr) { return *(const GAS T*)ptr; }
template <class T> __device__ __forceinline__ void stgp(void* ptr, T v) { *(GAS T*)ptr = v; }
__device__ __forceinline__ unsigned opaque(unsigned v) { asm volatile("" : "+v"(v)); return v; }
__device__ __forceinline__ int lane_id() { unsigned m = ~0u; asm volatile("" : "+s"(m)); return (int)__builtin_amdgcn_mbcnt_hi(m, __builtin_amdgcn_mbcnt_lo(m, 0u)); }
__device__ __forceinline__ int otid(int wave) { return (int)opaque((unsigned)((wave << 6) | lane_id())); }
__device__ __forceinline__ f32x4 mfma16(bf16x8 a, bf16x8 b, f32x4 c) { return __builtin_amdgcn_mfma_f32_16x16x32_bf16(a, b, c, 0, 0, 0); }

namespace pg8 {
constexpr int BM = 256, BK = 64, HALF = 128, HTB = HALF * BK * 2, STAGE_BYTES = 8 * HTB, NXCD = 8, WGM = 8;
__device__ __forceinline__ int lds_byte(int r, int c) { const int st = (r >> 4) * 2 + (c >> 5), rr = r & 15, cc = c & 31, ob = rr * 64 + cc * 2; return st * 1024 + (ob ^ (((ob >> 9) & 1) << 5)); }
__device__ __forceinline__ void stage_rc(int b, int& R, int& C) { const int st = b / 1024, sb = b % 1024, swz = sb ^ (((sb >> 9) & 1) << 5); R = (st >> 1) * 16 + swz / 64; C = (st & 1) * 32 + (swz % 64) / 2; }
__device__ __forceinline__ int perm32(int rho) { const int n = rho >> 4, i = rho & 15; return 8 * (i >> 2) + 4 * n + (i & 3); }
struct Unit { int pm, pn, k0, nt, split, tidx; };
struct Gemm { const bf16_t* A; const bf16_t* Bt; int M, N, K, wave; };
struct StaticOrder {
    int nM, nN, nwg, G, c, ntFull, KS, nfull;
    __device__ __forceinline__ void init(int M, int N, int K, int G_, int c_, int ksplit) {
        nM = M / BM; nN = N / BM; nwg = nM * nN; G = G_; c = c_; ntFull = K / BK; KS = ksplit; nfull = ksplit > 1 ? (nwg / G) * G : nwg; }
    __device__ __forceinline__ void tile(int wgid, Unit& u) const {
        { const int q = nwg / NXCD, r = nwg % NXCD, xcd = wgid % NXCD, off = wgid / NXCD; wgid = (xcd < r ? xcd * (q + 1) : r * (q + 1) + (xcd - r) * q) + off; }
        const int nig = WGM * nN, gid = wgid / nig, fm = gid * WGM, gsz = (nM - fm) < WGM ? (nM - fm) : WGM;
        u.pm = fm + ((wgid % nig) % gsz); u.pn = (wgid % nig) / gsz; }
    __device__ __forceinline__ bool next(int i, Unit& u) const {
        const int L = i * G + c, L2 = L - nfull;
        const bool full = L < nfull;
        if (!full && L2 >= (nwg - nfull) * KS) return false;
        const int wg = full ? L : nfull + L2 / KS;
        const int nts = full ? ntFull : ntFull / KS;
        const int k0 = full ? 0 : (L2 % KS) * nts * BK;
        int wgid = wg;
        { const int q = nwg / NXCD, r = nwg % NXCD, xcd = wgid % NXCD, off = wgid / NXCD; wgid = (xcd < r ? xcd * (q + 1) : r * (q + 1) + (xcd - r) * q) + off; }
        const int nig = WGM * nN, gid = wgid / nig, fm = gid * WGM, gsz = (nM - fm) < WGM ? (nM - fm) : WGM;
        u.pm = fm + ((wgid % nig) % gsz); u.pn = (wgid % nig) / gsz; u.k0 = k0; u.nt = nts; u.split = full ? 0 : 1; u.tidx = full ? 0 : L2 / KS;
        return true;
    }
};
template <class Epi>
__device__ __forceinline__ void gemm_phase(LAS unsigned char* lds, const Gemm g, const StaticOrder& S, const Epi& E) {
    const int tid = otid(g.wave), wid = __builtin_amdgcn_readfirstlane(tid >> 6), lane = tid & 63, wr = wid >> 2, wc = wid & 3, fr = lane & 15, fq = lane >> 4;
    const int K = g.K;
    unsigned voffA[2], voffB[2];
#pragma unroll
    for (int i = 0; i < 2; ++i) { int R, C; stage_rc(tid * 16 + i * 8192, R, C); const int Rb = Epi::PERM ? ((R & ~31) + perm32(R & 31)) : R;
        voffA[i] = (unsigned)(R * K + C) * 2u; voffB[i] = (unsigned)(Rb * K + C) * 2u; }
    const size_t kstep = (size_t)(BK * 2);
    const size_t hstep = (size_t)HALF * K * 2;
    const size_t tstep = 2 * hstep;
    const unsigned ldsw = (unsigned)wid * 1024u;
    const int aoff = lds_byte(wr * 64 + fr, fq * 8), boff = lds_byte(wc * 32 + fr, fq * 8);
#define PG8_SA(b, h) (((b) * 2 + (h)) * HTB)
#define PG8_SB(b, h) ((4 + (b) * 2 + (h)) * HTB)
#define PG8_STAGE(bufoff, gbase, voff) do { _Pragma("unroll") for (int _i = 0; _i < 2; ++_i) \
        __builtin_amdgcn_global_load_lds((const unsigned*)((const char*)(gbase) + (voff)[_i]), (LAS unsigned*)(lds + (bufoff) + ldsw + _i * 8192), 16, 0, 0); } while (0)
#define PG8_LDA(dst, b, h) do { _Pragma("unroll") for (int m = 0; m < 4; ++m) _Pragma("unroll") for (int k = 0; k < 2; ++k) dst[m][k] = *(const LAS bf16x8*)(lds + PG8_SA(b, h) + aoff + m * 2048 + k * 1024); } while (0)
#define PG8_LDB(dst, b, h) do { _Pragma("unroll") for (int n = 0; n < 2; ++n) _Pragma("unroll") for (int k = 0; k < 2; ++k) dst[n][k] = *(const LAS bf16x8*)(lds + PG8_SB(b, h) + boff + n * 2048 + k * 1024); } while (0)
#define PG8_MMA(ai, bj, At, Bt) do { __builtin_amdgcn_s_setprio(1); _Pragma("unroll") for (int m = 0; m < 4; ++m) _Pragma("unroll") for (int n = 0; n < 2; ++n) _Pragma("unroll") for (int k = 0; k < 2; ++k) \
        acc[ai][bj][m][n] = __builtin_amdgcn_mfma_f32_16x16x32_bf16(Bt[n][k], At[m][k], acc[ai][bj][m][n], 0, 0, 0); __builtin_amdgcn_s_setprio(0); } while (0)
#define PG8_WAIT_V(n) asm volatile("s_waitcnt vmcnt(" #n ")" ::: "memory")
#define PG8_WAIT_L(n) asm volatile("s_waitcnt lgkmcnt(" #n ")" ::: "memory")
#define PG8_BAR __builtin_amdgcn_s_barrier()
#define PG8_SCHED __builtin_amdgcn_sched_barrier(0)
    Unit cur, nxt; int ui = 0;
    if (!S.next(0, cur)) return;
    f32x4 acc[2][2][4][2];
#pragma unroll
    for (int a = 0; a < 2; ++a)
#pragma unroll
        for (int b = 0; b < 2; ++b)
#pragma unroll
            for (int m = 0; m < 4; ++m)
#pragma unroll
                for (int n = 0; n < 2; ++n) acc[a][b][m][n] = (f32x4){0.f, 0.f, 0.f, 0.f};
    bf16x8 At[4][2], B0[2][2], B1[2][2];
    const char* cA = (const char*)g.A + (size_t)cur.pm * tstep + (size_t)cur.k0 * 2; const char* cB = (const char*)g.Bt + (size_t)cur.pn * tstep + (size_t)cur.k0 * 2;
    PG8_STAGE(PG8_SB(0, 0), cB, voffB); PG8_STAGE(PG8_SA(0, 0), cA, voffA); PG8_STAGE(PG8_SB(0, 1), cB + hstep, voffB); PG8_STAGE(PG8_SA(0, 1), cA + hstep, voffA);
    if (wr == 1) PG8_BAR;
    PG8_WAIT_V(4); PG8_BAR;
    PG8_STAGE(PG8_SB(1, 0), cB + kstep, voffB); PG8_STAGE(PG8_SA(1, 0), cA + kstep, voffA); PG8_STAGE(PG8_SB(1, 1), cB + hstep + kstep, voffB);
    PG8_WAIT_V(6); PG8_BAR;
    for (;;) {
        const bool has_next = S.next(ui + 1, nxt);
        const char* nA = has_next ? (const char*)g.A + (size_t)nxt.pm * tstep + (size_t)nxt.k0 * 2 : cA; const char* nB = has_next ? (const char*)g.Bt + (size_t)nxt.pn * tstep + (size_t)nxt.k0 * 2 : cB;
        const int nt = cur.nt;
        for (int t = 0; t < nt; t += 2) {
            const bool last = (t == nt - 2);
            const char* a1 = cA + (size_t)(t + 1) * kstep;
            const char* a2 = last ? nA : cA + (size_t)(t + 2) * kstep; const char* b2 = last ? nB : cB + (size_t)(t + 2) * kstep;
            const char* a3 = a2 + kstep; const char* b3 = b2 + kstep;
            PG8_LDB(B0, 0, 0); PG8_SCHED; PG8_LDA(At, 0, 0); PG8_STAGE(PG8_SA(1, 1), a1 + hstep, voffA);
            PG8_WAIT_L(8); PG8_BAR; PG8_WAIT_L(0); PG8_MMA(0, 0, At, B0); PG8_BAR; PG8_SCHED;
            PG8_LDB(B1, 0, 1); PG8_STAGE(PG8_SB(0, 0), b2, voffB);
            PG8_BAR; PG8_WAIT_L(0); PG8_MMA(0, 1, At, B1); PG8_BAR;
            PG8_LDA(At, 0, 1); PG8_STAGE(PG8_SA(0, 0), a2, voffA);
            PG8_BAR; PG8_WAIT_L(0); PG8_MMA(1, 0, At, B0); PG8_BAR; PG8_SCHED;
            PG8_STAGE(PG8_SB(0, 1), b2 + hstep, voffB);
            PG8_WAIT_V(6); PG8_BAR; PG8_MMA(1, 1, At, B1); PG8_BAR;
            PG8_LDB(B0, 1, 0); PG8_SCHED; PG8_LDA(At, 1, 0); PG8_STAGE(PG8_SA(0, 1), a2 + hstep, voffA);
            PG8_WAIT_L(8); PG8_BAR; PG8_WAIT_L(0); PG8_MMA(0, 0, At, B0); PG8_BAR; PG8_SCHED;
            PG8_LDB(B1, 1, 1); PG8_STAGE(PG8_SB(1, 0), b3, voffB);
            PG8_BAR; PG8_WAIT_L(0); PG8_MMA(0, 1, At, B1); PG8_BAR;
            PG8_LDA(At, 1, 1); PG8_STAGE(PG8_SA(1, 0), a3, voffA);
            PG8_BAR; PG8_WAIT_L(0); PG8_MMA(1, 0, At, B0); PG8_BAR; PG8_SCHED;
            PG8_STAGE(PG8_SB(1, 1), b3 + hstep, voffB);
            PG8_WAIT_V(6); PG8_BAR; PG8_MMA(1, 1, At, B1); PG8_BAR;
        }
        E(acc, cur, wr, wc, fr, fq);
        if (!has_next) break;
#pragma unroll
        for (int a = 0; a < 2; ++a)
#pragma unroll
            for (int b = 0; b < 2; ++b)
#pragma unroll
                for (int m = 0; m < 4; ++m)
#pragma unroll
                    for (int n = 0; n < 2; ++n) acc[a][b][m][n] = (f32x4){0.f, 0.f, 0.f, 0.f};
        cur = nxt; cA = nA; cB = nB; ++ui;
    }
    PG8_WAIT_V(0);
    if (wr == 0) PG8_BAR;
    PG8_BAR;
#undef PG8_SA
#undef PG8_SB
#undef PG8_STAGE
#undef PG8_LDA
#undef PG8_LDB
#undef PG8_MMA
#undef PG8_WAIT_V
#undef PG8_WAIT_L
#undef PG8_BAR
#undef PG8_SCHED
}
}

__device__ __forceinline__ int row_pos(int row) { return row < MP ? (row & (TP - 1)) : TP + ((row - MP) & (TS - 1)); }
__device__ __forceinline__ int row_seq(int row) { return row < MP ? (row >> 11) : 8 + ((row - MP) >> 6); }

struct EpiIn {
    static constexpr bool PERM = true;
    float* out; unsigned char* ws; const float* lbl;
    template <int SEG>
    __device__ __forceinline__ void run(const f32x4 (&acc)[2][2][4][2], const pg8::Unit& u, int wr, int wc, int fr, int fq) const {
        const float* rope = (const float*)(ws + WS_ROPE);
#pragma unroll
        for (int ai = 0; ai < 2; ++ai)
#pragma unroll
            for (int m = 0; m < 4; ++m) {
                const int row = (int)opaque((unsigned)(u.pm * 256 + ai * 128 + wr * 64 + m * 16 + fr));
#pragma unroll
                for (int bj = 0; bj < 2; ++bj) {
                    const int c0 = u.pn * 256 + bj * 128 + wc * 32 + 8 * fq;
                    float v[8];
#pragma unroll
                    for (int i = 0; i < 4; ++i) { v[i] = acc[ai][bj][m][0][i]; v[4 + i] = acc[ai][bj][m][1][i]; }
                    if (SEG == 4 || SEG == 5 || SEG == 7 || SEG == 8) {
                        const bool doRope = (SEG == 8) ? (bj == 0 && wc == 0) : ((wc & 1) == 0);
                        if (doRope) {
                            const int pos = row_pos(row);
                            const f32x4* cs = (const f32x4*)(rope + (size_t)pos * 16);
                            f32x4 t0 = cs[0], t1 = cs[1], t2 = cs[2], t3 = cs[3];
                            const float cc[8] = {t0[0], t0[2], t1[0], t1[2], t2[0], t2[2], t3[0], t3[2]};
                            const float ss[8] = {t0[1], t0[3], t1[1], t1[3], t2[1], t2[3], t3[1], t3[3]};
#pragma unroll
                            for (int i = 0; i < 8; ++i) {
                                const float o = __shfl_xor(v[i], 16);
                                const float r0 = v[i] * cc[i] - o * ss[i], r1 = v[i] * cc[i] + o * ss[i];
                                v[i] = (fq == 0) ? r0 : ((fq == 1) ? r1 : v[i]);
                            }
                        }
                    }
                    if (SEG == 0 || SEG == 3) {
                        const int cc = c0 - (SEG == 0 ? 0 : 1536);
#pragma unroll
                        for (int i = 0; i < 8; ++i) v[i] = silu_f(v[i]);
                        u32x4 o = {pk2(v[0], v[1]), pk2(v[2], v[3]), pk2(v[4], v[5]), pk2(v[6], v[7])};
                        *(u32x4*)(ws + (SEG == 0 ? WS_QA : WS_GA) + ((size_t)row * 512 + cc) * 2) = o;
                    } else if (SEG == 1) {
                        const int cc = c0 - 512;
                        const f32x4 lba = *(const f32x4*)(lbl + cc), lbb = *(const f32x4*)(lbl + cc + 4);
                        float r[8];
#pragma unroll
                        for (int i = 0; i < 8; ++i) {
                            const float lb = i < 4 ? lba[i & 3] : lbb[i & 3];
                            const float sg = 1.f / (1.f + __expf(-v[i]));
                            r[i] = __logf(lb + (1.f - lb) * sg);
                        }
                        float* dst = (float*)(ws + WS_LFA) + (size_t)row * 512 + cc;
                        *(f32x4*)dst = (f32x4){r[0], r[1], r[2], r[3]}; *(f32x4*)(dst + 4) = (f32x4){r[4], r[5], r[6], r[7]};
                    } else if (SEG == 2) {
                        const int cc = c0 - 1024;
                        u32x4 o = {pk2(v[0], v[1]), pk2(v[2], v[3]), pk2(v[4], v[5]), pk2(v[6], v[7])};
                        *(u32x4*)(ws + WS_VA + ((size_t)row * 512 + cc) * 2) = o;
                    } else if (SEG == 4) {
                        const int cc = c0 - 2048;
                        const float qs = 0.18033688011112042f;
                        u32x4 o = {pk2(v[0] * qs, v[1] * qs), pk2(v[2] * qs, v[3] * qs), pk2(v[4] * qs, v[5] * qs), pk2(v[6] * qs, v[7] * qs)};
                        *(u32x4*)(ws + WS_QB + ((size_t)row * 512 + cc) * 2) = o;
                    } else if (SEG == 7) {
                        const int cc = c0 - 3072;
                        u32x4 o = {pk2(v[0], v[1]), pk2(v[2], v[3]), pk2(v[4], v[5]), pk2(v[6], v[7])};
                        *(u32x4*)(ws + WS_QI + ((size_t)row * 512 + cc) * 2) = o;
                    } else if (SEG == 5) {
                        const int cc = c0 - 2560;
                        float* dst = row < MP ? out + OFF_KP + (size_t)row * 256 + cc : out + OFF_KS + (size_t)(row - MP) * 256 + cc;
                        *(f32x4*)dst = (f32x4){v[0], v[1], v[2], v[3]}; *(f32x4*)(dst + 4) = (f32x4){v[4], v[5], v[6], v[7]};
                        u32x4 o = {pk2(v[0], v[1]), pk2(v[2], v[3]), pk2(v[4], v[5]), pk2(v[6], v[7])};
                        size_t kr = row < MP ? (size_t)row : (size_t)((row - MP) >> 6) * TKS + TP + ((row - MP) & 63);
                        *(u32x4*)(ws + (row < MP ? WS_KBP : WS_KBS) + (kr * 256 + cc) * 2) = o;
                    } else if (SEG == 6) {
                        const int cc = c0 - 2816;
                        float* dst = row < MP ? out + OFF_VP + (size_t)row * 256 + cc : out + OFF_VS + (size_t)(row - MP) * 256 + cc;
                        *(f32x4*)dst = (f32x4){v[0], v[1], v[2], v[3]}; *(f32x4*)(dst + 4) = (f32x4){v[4], v[5], v[6], v[7]};
                        if (row < MP) {
                            const int b = row >> 11, t = row & 2047;
                            bf16_t* vt = (bf16_t*)(ws + WS_VTP) + ((size_t)b * 256 + cc) * TP + t;
#pragma unroll
                            for (int i = 0; i < 8; ++i) vt[(size_t)i * TP] = f2bf(v[i]);
                        } else {
                            const int b = (row - MP) >> 6, t = TP + ((row - MP) & 63);
                            bf16_t* vt = (bf16_t*)(ws + WS_VTS) + ((size_t)b * 256 + cc) * TKS + t;
#pragma unroll
                            for (int i = 0; i < 8; ++i) vt[(size_t)i * TKS] = f2bf(v[i]);
                        }
                    } else if (SEG == 8) {
                        if (bj == 0) {
                            const int cc = wc * 32 + 8 * fq;
                            if (wc < 2) {
                                float* dst = row < MP ? out + OFF_KIP + (size_t)row * 64 + cc : out + OFF_KIS + (size_t)(row - MP) * 64 + cc;
                                *(f32x4*)dst = (f32x4){v[0], v[1], v[2], v[3]}; *(f32x4*)(dst + 4) = (f32x4){v[4], v[5], v[6], v[7]};
                                u32x4 o = {pk2(v[0], v[1]), pk2(v[2], v[3]), pk2(v[4], v[5]), pk2(v[6], v[7])};
                                size_t kr = row < MP ? (size_t)row : (size_t)((row - MP) >> 6) * TKS + TP + ((row - MP) & 63);
                                *(u32x4*)(ws + (row < MP ? WS_KIP : WS_KIS) + (kr * 64 + cc) * 2) = o;
                            } else if (wc == 2 && fq == 0) {
                                const float sc = 0.044194173824159216f;
                                float* dst = (float*)(ws + WS_WI) + (size_t)row * 8;
                                *(f32x4*)dst = (f32x4){v[0] * sc, v[1] * sc, v[2] * sc, v[3] * sc}; *(f32x4*)(dst + 4) = (f32x4){v[4] * sc, v[5] * sc, v[6] * sc, v[7] * sc};
                            }
                        }
                    }
                }
            }
    }
    __device__ __forceinline__ void operator()(const f32x4 (&acc)[2][2][4][2], const pg8::Unit& u, int wr, int wc, int fr, int fq) const {
        const int pn = u.pn;
        if (pn < 2) run<0>(acc, u, wr, wc, fr, fq);
        else if (pn < 4) run<1>(acc, u, wr, wc, fr, fq);
        else if (pn < 6) run<2>(acc, u, wr, wc, fr, fq);
        else if (pn < 8) run<3>(acc, u, wr, wc, fr, fq);
        else if (pn < 10) run<4>(acc, u, wr, wc, fr, fq);
        else if (pn == 10) run<5>(acc, u, wr, wc, fr, fq);
        else if (pn == 11) run<6>(acc, u, wr, wc, fr, fq);
        else if (pn < 14) run<7>(acc, u, wr, wc, fr, fq);
        else run<8>(acc, u, wr, wc, fr, fq);
    }
};

template <int MODE> struct EpiRes {
    static constexpr bool PERM = false;
    const float* xp; const float* xs; float* dst; const float* mod; float* part;
    __device__ __forceinline__ void operator()(const f32x4 (&acc)[2][2][4][2], const pg8::Unit& u, int wr, int wc, int fr, int fq) const {
        if (u.split) {
            const int ks = u.k0 / (u.nt * 64);
            float* pb = part + (size_t)(u.tidx * (MODE == 0 ? 4 : 16) + ks) * 65536;
#pragma unroll
            for (int ai = 0; ai < 2; ++ai)
#pragma unroll
                for (int m = 0; m < 4; ++m) {
                    const int rloc = (int)opaque((unsigned)(ai * 128 + wr * 64 + m * 16 + fr));
#pragma unroll
                    for (int bj = 0; bj < 2; ++bj)
#pragma unroll
                        for (int n = 0; n < 2; ++n) *(f32x4*)(pb + rloc * 256 + bj * 128 + wc * 32 + n * 16 + 4 * fq) = acc[ai][bj][m][n];
                }
            return;
        }
#pragma unroll
        for (int ai = 0; ai < 2; ++ai)
#pragma unroll
            for (int m = 0; m < 4; ++m) {
                const int row = (int)opaque((unsigned)(u.pm * 256 + ai * 128 + wr * 64 + m * 16 + fr));
                const float* gate = mod + (size_t)row_seq(row) * 6144 + (MODE == 0 ? 2048 : 5120);
                const float* src = MODE == 0 ? (row < MP ? xp + (size_t)row * D : xs + (size_t)(row - MP) * D) : dst + (size_t)row * D;
                float* drow = dst + (size_t)row * D;
#pragma unroll
                for (int bj = 0; bj < 2; ++bj)
#pragma unroll
                    for (int n = 0; n < 2; ++n) {
                        const int c = u.pn * 256 + bj * 128 + wc * 32 + n * 16 + 4 * fq;
                        const f32x4 g = *(const f32x4*)(gate + c), x = *(const f32x4*)(src + c);
                        *(f32x4*)(drow + c) = x + g * acc[ai][bj][m][n];
                    }
            }
    }
};

struct EpiFF1 {
    static constexpr bool PERM = true;
    bf16_t* U;
    __device__ __forceinline__ void operator()(const f32x4 (&acc)[2][2][4][2], const pg8::Unit& u, int wr, int wc, int fr, int fq) const {
#pragma unroll
        for (int ai = 0; ai < 2; ++ai)
#pragma unroll
            for (int m = 0; m < 4; ++m) {
                const int row = (int)opaque((unsigned)(u.pm * 256 + ai * 128 + wr * 64 + m * 16 + fr));
#pragma unroll
                for (int bj = 0; bj < 2; ++bj) {
                    const int c0 = u.pn * 256 + bj * 128 + wc * 32 + 8 * fq;
                    float v[8];
#pragma unroll
                    for (int i = 0; i < 4; ++i) { v[i] = acc[ai][bj][m][0][i]; v[4 + i] = acc[ai][bj][m][1][i]; }
#pragma unroll
                    for (int i = 0; i < 8; ++i) { const float r = fmaxf(v[i], 0.f); v[i] = r * r; }
                    u32x4 o = {pk2(v[0], v[1]), pk2(v[2], v[3]), pk2(v[4], v[5]), pk2(v[6], v[7])};
                    *(u32x4*)(U + (size_t)row * DFF + c0) = o;
                }
            }
    }
};

__device__ __forceinline__ void transpose_tile(int wave, const float* src, int ldin, int ncols_valid, bf16_t* dst, int ldout, int k0, int n0, float* tile) {
    const int t = otid(wave);
    {
        const int c4 = (t & 31) * 4, r = t >> 5;
        const int n = n0 + c4;
        f32x4 v[4];
#pragma unroll
        for (int i = 0; i < 4; ++i) v[i] = (n < ncols_valid) ? *(const f32x4*)(src + (size_t)(k0 + r + 16 * i) * ldin + n) : (f32x4){0.f, 0.f, 0.f, 0.f};
#pragma unroll
        for (int i = 0; i < 4; ++i) {
            float* tr = tile + (r + 16 * i) * 129 + c4;
            tr[0] = v[i][0]; tr[1] = v[i][1]; tr[2] = v[i][2]; tr[3] = v[i][3];
        }
    }
    __syncthreads();
#pragma unroll
    for (int h = 0; h < 2; ++h) {
        const int id = t + 512 * h, ko = id & 7, n = id >> 3;
        const float* tc = tile + (ko * 8) * 129 + n;
        const u32x4 o = {pk2(tc[0], tc[129]), pk2(tc[2 * 129], tc[3 * 129]), pk2(tc[4 * 129], tc[5 * 129]), pk2(tc[6 * 129], tc[7 * 129])};
        *(u32x4*)(dst + (size_t)(n0 + n) * ldout + k0 + ko * 8) = o;
    }
    __syncthreads();
}

__device__ __forceinline__ void mod_item(const Params& p, int it, float* smem) {
    float* sc = smem;
    float* red = smem + 16384;
    const int tid = otid(p.wave);
    for (int idx = tid; idx < 16384; idx += NTHREADS) {
        const int s = idx & 15, k = idx >> 4;
        const float c = s < 8 ? p.in[6][s * 1024 + k] : p.in[7][(s - 8) * 1024 + k];
        sc[idx] = silu_f(c);
    }
    __syncthreads();
    const int cl = tid & 63, kg = tid >> 6, col = it * 64 + cl;
    float acc[16];
#pragma unroll
    for (int s = 0; s < 16; ++s) acc[s] = 0.f;
    const float* wm = p.in[8];
#pragma unroll 16
    for (int kk = 0; kk < 128; ++kk) {
        const int k = kg * 128 + kk;
        const float w = wm[(size_t)k * 6144 + col];
        const f32x4* sv = (const f32x4*)(sc + k * 16);
#pragma unroll
        for (int q = 0; q < 4; ++q) { const f32x4 s4 = sv[q]; acc[q * 4 + 0] += w * s4[0]; acc[q * 4 + 1] += w * s4[1]; acc[q * 4 + 2] += w * s4[2]; acc[q * 4 + 3] += w * s4[3]; }
    }
#pragma unroll
    for (int s = 0; s < 16; ++s) red[(kg * 16 + s) * 64 + cl] = acc[s];
    __syncthreads();
    float* mod = (float*)(p.ws + WS_MOD);
    for (int idx = tid; idx < 1024; idx += NTHREADS) {
        const int s = idx >> 6, c = idx & 63;
        float sum = p.in[9][it * 64 + c];
#pragma unroll
        for (int g = 0; g < 8; ++g) sum += red[(g * 16 + s) * 64 + c];
        mod[(size_t)s * 6144 + it * 64 + c] = sum;
    }
    __syncthreads();
}

__device__ __forceinline__ void sincos_acc(float ang, float& c, float& s) {
    const double a = (double)ang;
    const double q = rint(a * 0.63661977236758134308);
    double r = a - q * 1.5707963267948966192;
    r -= q * 6.123233995736766036e-17;
    const double r2 = r * r;
    double sp = r * (1.0 + r2 * (-1.0 / 6 + r2 * (1.0 / 120 + r2 * (-1.0 / 5040 + r2 * (1.0 / 362880 + r2 * (-1.0 / 39916800 + r2 * (1.0 / 6227020800.0)))))));
    double cp = 1.0 + r2 * (-0.5 + r2 * (1.0 / 24 + r2 * (-1.0 / 720 + r2 * (1.0 / 40320 + r2 * (-1.0 / 3628800 + r2 * (1.0 / 479001600.0 + r2 * (-1.0 / 87178291200.0)))))));
    const int qi = ((int)(long long)q) & 3;
    double cc = (qi == 0) ? cp : (qi == 1) ? -sp : (qi == 2) ? -cp : sp;
    double ss = (qi == 0) ? sp : (qi == 1) ? cp : (qi == 2) ? -sp : -cp;
    c = (float)cc; s = (float)ss;
}

__device__ __forceinline__ void phase0(const Params& p, float* smem) {
    const int tid = otid(p.wave);
    constexpr int N_MOD = 96, N_WIN = 480, N_WOUT = 128, N_F1 = 512, N_F2 = 512, N_CV = 512, N_CK = 256, N_CKI = 64, N_ROPE = 33;
    constexpr int TOTAL = N_MOD + N_WIN + N_WOUT + N_F1 + N_F2 + N_CV + N_CK + N_CKI + N_ROPE;
    if (blockIdx.x == 0 && tid == 0) *(int*)(p.ws + WS_QUEUE) = 0;
    int* counter = (int*)(p.ws + WS_QUEUE) + 16;
    volatile int* slot = (volatile int*)((unsigned char*)smem + LDS_BYTES - 16);
    int nxt_item = 0;
    if (tid == 0) nxt_item = atomicAdd(counter, 1);
    for (;;) {
        if (tid == 0) *slot = nxt_item;
        __syncthreads();
        const int item = *slot;
        __syncthreads();
        if (item >= TOTAL) break;
        if (tid == 0) nxt_item = atomicAdd(counter, 1);
        int it = item;
        if (it < N_MOD) { mod_item(p, it, smem); continue; }
        it -= N_MOD;
        if (it < N_WIN) { transpose_tile(p.wave, p.in[11], NIN, NIN, (bf16_t*)(p.ws + WS_WTIN), D, (it / 30) * 64, (it % 30) * 128, smem); continue; }
        it -= N_WIN;
        if (it < N_WOUT) { transpose_tile(p.wave, p.in[14], D, D, (bf16_t*)(p.ws + WS_WTOUT), D, (it / 8) * 64, (it % 8) * 128, smem); continue; }
        it -= N_WOUT;
        if (it < N_F1) { transpose_tile(p.wave, p.in[16], DFF, DFF, (bf16_t*)(p.ws + WS_WTF1), D, (it / 32) * 64, (it % 32) * 128, smem); continue; }
        it -= N_F1;
        if (it < N_F2) { transpose_tile(p.wave, p.in[17], D, D, (bf16_t*)(p.ws + WS_WTF2), DFF, (it / 8) * 64, (it % 8) * 128, smem); continue; }
        it -= N_F2;
        if (it < N_CV) { const int b = it >> 6, r = it & 63; transpose_tile(p.wave, p.in[3] + (size_t)b * TP * 256, 256, 256, (bf16_t*)(p.ws + WS_VTS) + (size_t)b * 256 * TKS, TKS, (r >> 1) * 64, (r & 1) * 128, smem); continue; }
        it -= N_CV;
        if (it < N_CK) {
#pragma unroll
            for (int rep = 0; rep < 4; ++rep) {
                const size_t e = ((size_t)it * 4 + rep) * 4096 + tid * 8; const int b = (int)(e / ((size_t)TP * 256)); const size_t rem = e % ((size_t)TP * 256);
                const f32x4 a = *(const f32x4*)(p.in[2] + e), c = *(const f32x4*)(p.in[2] + e + 4);
                u32x4 o = {pk2(a[0], a[1]), pk2(a[2], a[3]), pk2(c[0], c[1]), pk2(c[2], c[3])};
                *(u32x4*)(p.ws + WS_KBS + ((size_t)b * TKS * 256 + rem) * 2) = o;
            }
            continue;
        }
        it -= N_CK;
        if (it < N_CKI) {
#pragma unroll
            for (int rep = 0; rep < 4; ++rep) {
                const size_t e = ((size_t)it * 4 + rep) * 4096 + tid * 8; const int b = (int)(e / ((size_t)TP * 64)); const size_t rem = e % ((size_t)TP * 64);
                const f32x4 a = *(const f32x4*)(p.in[4] + e), c = *(const f32x4*)(p.in[4] + e + 4);
                u32x4 o = {pk2(a[0], a[1]), pk2(a[2], a[3]), pk2(c[0], c[1]), pk2(c[2], c[3])};
                *(u32x4*)(p.ws + WS_KIS + ((size_t)b * TKS * 64 + rem) * 2) = o;
            }
            continue;
        }
        it -= N_CKI;
        {
            if (it == 0) { const float l0 = p.in[12][tid], l1 = p.in[12][512 + tid]; ((float*)(p.ws + WS_LB))[tid] = 1.f / (1.f + expf(l1 - l0)); }
            const int e = it * 512 + tid;
            if (e < TKS * 8) {
                const int pos = e >> 3, i = e & 7;
                const float inv = (float)exp(-(double)i * 0.125 * 13.122363377404328);
                const float ang = (float)pos * inv;
                float c, s; sincos_acc(ang, c, s);
                float* rope = (float*)(p.ws + WS_ROPE);
                rope[(size_t)pos * 16 + 2 * i] = c; rope[(size_t)pos * 16 + 2 * i + 1] = s;
            }
        }
    }
}

template <int MODE> __device__ __forceinline__ void norm_phase(const Params& p) {
    const int tn = otid(p.wave); const int lane = tn & 63, wv = tn >> 6;
    const float* mod = (const float*)(p.ws + WS_MOD);
    const float* nw = MODE == 0 ? p.in[10] : (MODE == 1 ? p.in[15] : p.in[18]);
    f32x4 w4[4];
#pragma unroll
    for (int j = 0; j < 4; ++j) w4[j] = *(const f32x4*)(nw + lane * 4 + 256 * j);
    for (int row = blockIdx.x * 8 + wv; row < MT; row += gridDim.x * 8) {
        const float* src = MODE == 0 ? (row < MP ? p.in[0] + (size_t)row * D : p.in[1] + (size_t)(row - MP) * D) : p.out + OFF_Y + (size_t)row * D;
        f32x4 v[4]; float s = 0.f;
#pragma unroll
        for (int j = 0; j < 4; ++j) v[j] = *(const f32x4*)(src + lane * 4 + 256 * j);
        if (MODE != 0 && p.ksplit > 1) {
            const int pm4 = (row >> 8) * 4;
            const float* part = (const float*)(p.ws + (MODE == 1 ? WS_R : WS_H));
            const float* gate = mod + (size_t)row_seq(row) * 6144 + (MODE == 1 ? 2048 : 5120);
#pragma unroll
            for (int j = 0; j < 4; ++j) {
                int hit = -1;
#pragma unroll
                for (int t = 0; t < 8; ++t) hit = (t < p.ntail && p.tail[t] == pm4 + j) ? t : hit;
                if (hit >= 0) {
                    constexpr int NSL = MODE == 1 ? 4 : 16;
                    const float* pp = part + (size_t)hit * NSL * 65536 + (row & 255) * 256 + lane * 4;
                    f32x4 sum = (*(const f32x4*)pp + *(const f32x4*)(pp + 65536)) + (*(const f32x4*)(pp + 2 * 65536) + *(const f32x4*)(pp + 3 * 65536));
#pragma unroll
                    for (int sl = 4; sl < NSL; sl += 4)
                        sum = sum + ((*(const f32x4*)(pp + (size_t)sl * 65536) + *(const f32x4*)(pp + (size_t)(sl + 1) * 65536)) + (*(const f32x4*)(pp + (size_t)(sl + 2) * 65536) + *(const f32x4*)(pp + (size_t)(sl + 3) * 65536)));
                    const f32x4 g = *(const f32x4*)(gate + lane * 4 + 256 * j);
                    if (MODE == 1) {
                        const float* xrow = row < MP ? p.in[0] + (size_t)row * D : p.in[1] + (size_t)(row - MP) * D;
                        v[j] = *(const f32x4*)(xrow + lane * 4 + 256 * j) + g * sum;
                        *(f32x4*)(p.out + OFF_Y + (size_t)row * D + lane * 4 + 256 * j) = v[j];
                    } else v[j] = v[j] + g * sum;
                }
            }
        }
#pragma unroll
        for (int j = 0; j < 4; ++j) s += v[j][0] * v[j][0] + v[j][1] * v[j][1] + v[j][2] * v[j][2] + v[j][3] * v[j][3];
        s = wave_sum(s);
        const float rstd = rsqrtf(s * (1.f / D) + 1e-6f);
        if (MODE == 2) {
            float* dst = p.out + OFF_Y + (size_t)row * D;
#pragma unroll
            for (int j = 0; j < 4; ++j) *(f32x4*)(dst + lane * 4 + 256 * j) = v[j] * rstd * w4[j];
        } else {
            const float* mrow = mod + (size_t)row_seq(row) * 6144 + (MODE == 0 ? 0 : 3072);
            bf16_t* dst = (bf16_t*)(p.ws + WS_H) + (size_t)row * D;
#pragma unroll
            for (int j = 0; j < 4; ++j) {
                const f32x4 sh = *(const f32x4*)(mrow + lane * 4 + 256 * j), sc = *(const f32x4*)(mrow + 1024 + lane * 4 + 256 * j);
                const f32x4 r = v[j] * rstd * w4[j] * (sc + 1.f) + sh;
                u32x2 o = {pk2(r[0], r[1]), pk2(r[2], r[3])};
                *(u32x2*)(dst + lane * 4 + 256 * j) = o;
            }
        }
    }
}

constexpr int HG_LF = 0;
constexpr int HG_TOT = HG_LF + 64 * 128 * 4;
constexpr int HG_BREL = HG_TOT + 4 * 128 * 4;
constexpr int HG_QE = HG_BREL + 4 * 128 * 4;
constexpr int HG_KE = HG_QE + 64 * 272;
constexpr int HG_KET = HG_KE + 64 * 272;
constexpr int HG_VT = HG_KET + 128 * 144;
constexpr int HG_ST = HG_VT + 128 * 144;
constexpr int HG_PP = HG_ST + 128 * 272;
constexpr int HG_SSQ = HG_PP + 64 * 144;
constexpr int HG_RS = HG_SSQ + 8 * 64 * 4;
constexpr int HG_ER = HG_RS + 64 * 4;
constexpr int HG_EBR = HG_ER + 128 * 4;
constexpr int HG_END = HG_EBR + 128 * 4;
static_assert(HG_END <= LDS_BYTES, "hgrn LDS");

__device__ __forceinline__ void hgrn_unit(const Params& p, unsigned char* smem, int grp, int b, int hh) {
    const int tid = otid(p.wave), lane = tid & 63, w = tid >> 6, l15 = lane & 15, lg = lane >> 4;
    const int nch = grp == 0 ? TP / 64 : 1;
    const int row0 = grp == 0 ? b * TP : MP + b * TS;
    float* LF = (float*)(smem + HG_LF); float* TOT = (float*)(smem + HG_TOT); float* BREL = (float*)(smem + HG_BREL); float* SSQ = (float*)(smem + HG_SSQ);
    float* RS = (float*)(smem + HG_RS); float* ER = (float*)(smem + HG_ER); float* EBR = (float*)(smem + HG_EBR);
    const bf16_t* qA = (const bf16_t*)(p.ws + WS_QA); const float* lfA = (const float*)(p.ws + WS_LFA);
    const bf16_t* vA = (const bf16_t*)(p.ws + WS_VA); const bf16_t* gA = (const bf16_t*)(p.ws + WS_GA);
    bf16_t* mix = (bf16_t*)(p.ws + WS_H);
    f32x4 Sacc[8];
    if (grp == 0) {
#pragma unroll
        for (int kt = 0; kt < 8; ++kt) Sacc[kt] = (f32x4){0.f, 0.f, 0.f, 0.f};
    } else {
        const float* s0 = p.in[5] + ((size_t)(b * 4 + hh) * 128) * 128;
#pragma unroll
        for (int kt = 0; kt < 8; ++kt)
#pragma unroll
            for (int j = 0; j < 4; ++j) Sacc[kt][j] = s0[(size_t)(kt * 16 + lg * 4 + j) * 128 + 16 * w + l15];
    }
    const int t0 = tid >> 4, oc = tid & 15;
    const int kc = tid & 127, part = tid >> 7;
    f32x4 nlf[2][2]; u32x4 nq[2], nv[2], ng[2];
    {
#pragma unroll
        for (int h = 0; h < 2; ++h) {
            const unsigned eo = (unsigned)((row0 + t0 + 32 * h) * 512 + hh * 128 + oc * 8);
            nlf[h][0] = ldg32<f32x4>(lfA, eo * 4u); nlf[h][1] = ldg32<f32x4>(lfA, eo * 4u + 16u);
            nq[h] = ldg32<u32x4>(qA, eo * 2u); nv[h] = ldg32<u32x4>(vA, eo * 2u); ng[h] = ldg32<u32x4>(gA, eo * 2u);
        }
    }
    for (int c = 0; c < nch; ++c) {
        const int tok0 = row0 + c * 64;
        f32x4 clf[2][2]; u32x4 cq[2], cg[2];
#pragma unroll
        for (int h = 0; h < 2; ++h) {
            const int t = t0 + 32 * h;
            const int tsw = (((t >> 3) ^ (oc & 7)) << 4) + (t & 7) * 2;
            clf[h][0] = nlf[h][0]; clf[h][1] = nlf[h][1]; cq[h] = nq[h]; cg[h] = ng[h];
            *(f32x4*)(LF + t * 128 + oc * 8) = clf[h][0]; *(f32x4*)(LF + t * 128 + oc * 8 + 4) = clf[h][1];
#pragma unroll
            for (int i = 0; i < 4; ++i) {
                *(bf16_t*)(smem + HG_VT + (oc * 8 + 2 * i) * 144 + tsw) = (bf16_t)(nv[h][i] & 0xffffu);
                *(bf16_t*)(smem + HG_VT + (oc * 8 + 2 * i + 1) * 144 + tsw) = (bf16_t)(nv[h][i] >> 16);
            }
        }
        if (c + 1 < nch) {
#pragma unroll
            for (int h = 0; h < 2; ++h) {
                const unsigned eo = (unsigned)((tok0 + 64 + t0 + 32 * h) * 512 + hh * 128 + oc * 8);
                nlf[h][0] = ldg32<f32x4>(lfA, eo * 4u); nlf[h][1] = ldg32<f32x4>(lfA, eo * 4u + 16u);
                nq[h] = ldg32<u32x4>(qA, eo * 2u); nv[h] = ldg32<u32x4>(vA, eo * 2u); ng[h] = ldg32<u32x4>(gA, eo * 2u);
            }
        }
        __syncthreads();
        {
            float run = 0.f;
#pragma unroll
            for (int i = 0; i < 16; ++i) { const int t = part * 16 + i; run += LF[t * 128 + kc]; LF[t * 128 + kc] = run; }
            TOT[part * 128 + kc] = run;
        }
        __syncthreads();
        if (tid < 128) {
            const float t0s = TOT[tid], t1s = TOT[128 + tid], t2s = TOT[256 + tid], t3s = TOT[384 + tid];
            const float r = LF[31 * 128 + tid] + t0s;
            const float bl = t0s + t1s + t2s + t3s;
            ER[tid] = __expf(r); EBR[tid] = __expf(bl - r);
            BREL[tid] = -r; BREL[128 + tid] = t0s - r; BREL[256 + tid] = t0s + t1s - r; BREL[384 + tid] = t0s + t1s + t2s - r;
        }
        __syncthreads();
#pragma unroll
        for (int h = 0; h < 2; ++h) {
            const int t = t0 + 32 * h, pt = t >> 4;
            const int tsw = (((t >> 3) ^ (oc & 7)) << 4) + (t & 7) * 2;
            const f32x4 b0 = *(const f32x4*)(LF + t * 128 + oc * 8), b1 = *(const f32x4*)(LF + t * 128 + oc * 8 + 4);
            const f32x4 r0 = *(const f32x4*)(BREL + pt * 128 + oc * 8), r1 = *(const f32x4*)(BREL + pt * 128 + oc * 8 + 4);
            float qe[8], ke[8];
#pragma unroll
            for (int i = 0; i < 8; ++i) {
                const float bmr = (i < 4 ? b0[i & 3] : b1[i & 3]) + (i < 4 ? r0[i & 3] : r1[i & 3]);
                const float lfr = i < 4 ? clf[h][0][i & 3] : clf[h][1][i & 3];
                const unsigned qw = cq[h][i >> 1];
                const float q = __uint_as_float((i & 1) ? (qw & 0xffff0000u) : (qw << 16));
                qe[i] = q * __expf(bmr);
                ke[i] = (1.f - __expf(lfr)) * __expf(-bmr);
            }
            const u32x4 qp = {pk2(qe[0], qe[1]), pk2(qe[2], qe[3]), pk2(qe[4], qe[5]), pk2(qe[6], qe[7])};
            const u32x4 kp = {pk2(ke[0], ke[1]), pk2(ke[2], ke[3]), pk2(ke[4], ke[5]), pk2(ke[6], ke[7])};
            *(u32x4*)(smem + HG_QE + t * 272 + oc * 16) = qp;
            *(u32x4*)(smem + HG_KE + t * 272 + oc * 16) = kp;
#pragma unroll
            for (int i = 0; i < 4; ++i) {
                *(bf16_t*)(smem + HG_KET + (oc * 8 + 2 * i) * 144 + tsw) = (bf16_t)(kp[i] & 0xffffu);
                *(bf16_t*)(smem + HG_KET + (oc * 8 + 2 * i + 1) * 144 + tsw) = (bf16_t)(kp[i] >> 16);
            }
        }
#pragma unroll
        for (int kt = 0; kt < 8; ++kt) {
            const f32x4 er = *(const f32x4*)(ER + kt * 16 + lg * 4);
            Sacc[kt] = Sacc[kt] * er;
            u32x2 o = {pk2(Sacc[kt][0], Sacc[kt][1]), pk2(Sacc[kt][2], Sacc[kt][3])};
            *(u32x2*)(smem + HG_ST + (16 * w + l15) * 272 + (kt * 16 + lg * 4) * 2) = o;
        }
        __syncthreads();
#pragma unroll
        for (int e = 0; e < 2; ++e) {
            const int tile = 2 * w + e, ti = tile >> 2, si = tile & 3;
            f32x4 a = (f32x4){0.f, 0.f, 0.f, 0.f};
            if (si <= ti) {
#pragma unroll
                for (int kk = 0; kk < 4; ++kk) {
                    const bf16x8 af = *(const bf16x8*)(smem + HG_QE + (ti * 16 + l15) * 272 + (kk * 32 + lg * 8) * 2);
                    const bf16x8 bfr = *(const bf16x8*)(smem + HG_KE + (si * 16 + l15) * 272 + (kk * 32 + lg * 8) * 2);
                    a = mfma16(af, bfr, a);
                }
            }
#pragma unroll
            for (int j = 0; j < 4; ++j) {
                const int t = ti * 16 + lg * 4 + j, s = si * 16 + l15;
                const float val = (s <= t && si <= ti) ? a[j] : 0.f;
                *(bf16_t*)(smem + HG_PP + t * 144 + s * 2) = f2bf(val);
            }
        }
        __syncthreads();
        f32x4 oacc[4];
        {
            bf16x8 vf[2];
#pragma unroll
            for (int kk = 0; kk < 2; ++kk) vf[kk] = *(const bf16x8*)(smem + HG_VT + (16 * w + l15) * 144 + (((kk * 4 + lg) ^ (((16 * w + l15) >> 3) & 7)) << 4));
#pragma unroll
            for (int tt = 0; tt < 4; ++tt) {
                f32x4 a = (f32x4){0.f, 0.f, 0.f, 0.f};
#pragma unroll
                for (int kk = 0; kk < 2; ++kk) {
                    const bf16x8 pf = *(const bf16x8*)(smem + HG_PP + (tt * 16 + l15) * 144 + (kk * 32 + lg * 8) * 2);
                    a = mfma16(pf, vf[kk], a);
                }
#pragma unroll
                for (int kk = 0; kk < 4; ++kk) {
                    const bf16x8 qf = *(const bf16x8*)(smem + HG_QE + (tt * 16 + l15) * 272 + (kk * 32 + lg * 8) * 2);
                    const bf16x8 sf = *(const bf16x8*)(smem + HG_ST + (16 * w + l15) * 272 + (kk * 32 + lg * 8) * 2);
                    a = mfma16(qf, sf, a);
                }
                oacc[tt] = a;
            }
#pragma unroll
            for (int kt = 0; kt < 8; ++kt) {
#pragma unroll
                for (int kk = 0; kk < 2; ++kk) {
                    const bf16x8 kf = *(const bf16x8*)(smem + HG_KET + (kt * 16 + l15) * 144 + (((kk * 4 + lg) ^ (((kt * 16 + l15) >> 3) & 7)) << 4));
                    Sacc[kt] = mfma16(kf, vf[kk], Sacc[kt]);
                }
                const f32x4 ebr = *(const f32x4*)(EBR + kt * 16 + lg * 4);
                Sacc[kt] = Sacc[kt] * ebr;
            }
#pragma unroll
            for (int tt = 0; tt < 4; ++tt)
#pragma unroll
                for (int j = 0; j < 4; ++j) {
                    float s = oacc[tt][j] * oacc[tt][j];
                    s += __shfl_xor(s, 1); s += __shfl_xor(s, 2); s += __shfl_xor(s, 4); s += __shfl_xor(s, 8);
                    if (l15 == 0) SSQ[w * 64 + tt * 16 + lg * 4 + j] = s;
                }
        }
        __syncthreads();
        if (tid < 64) {
            float ss = 0.f;
#pragma unroll
            for (int ww = 0; ww < 8; ++ww) ss += SSQ[ww * 64 + tid];
            RS[tid] = rsqrtf(ss * (1.f / 128.f) + 1e-6f);
        }
        __syncthreads();
        {
            const float gn = p.in[13][hh * 128 + 16 * w + l15];
#pragma unroll
            for (int tt = 0; tt < 4; ++tt) {
                const f32x4 rs = *(const f32x4*)(RS + tt * 16 + lg * 4);
#pragma unroll
                for (int j = 0; j < 4; ++j)
                    *(bf16_t*)(smem + HG_QE + (tt * 16 + lg * 4 + j) * 272 + (16 * w + l15) * 2) = f2bf(oacc[tt][j] * rs[j] * gn);
            }
        }
        __syncthreads();
#pragma unroll
        for (int h = 0; h < 2; ++h) {
            const int t = t0 + 32 * h;
            const int tsw = (((t >> 3) ^ (oc & 7)) << 4) + (t & 7) * 2;
            const u32x4 ov = *(const u32x4*)(smem + HG_QE + t * 272 + oc * 16);
            u32x4 res;
#pragma unroll
            for (int i = 0; i < 4; ++i) {
                const float o0 = __uint_as_float(ov[i] << 16) * __uint_as_float(cg[h][i] << 16);
                const float o1 = __uint_as_float(ov[i] & 0xffff0000u) * __uint_as_float(cg[h][i] & 0xffff0000u);
                res[i] = pk2(o0, o1);
            }
            stgp<u32x4>((char*)mix + ((size_t)(tok0 + t) * D + hh * 128 + oc * 8) * 2, res);
        }
    }
    float* so = p.out + (grp == 0 ? OFF_HP : OFF_HS) + ((size_t)(b * 4 + hh) * 128) * 128;
#pragma unroll
    for (int kt = 0; kt < 8; ++kt)
#pragma unroll
        for (int j = 0; j < 4; ++j) so[(size_t)(kt * 16 + lg * 4 + j) * 128 + 16 * w + l15] = Sacc[kt][j];
    __syncthreads();
}

constexpr int DS_CNT = 0;
constexpr int DS_ML = DS_CNT + 2 * 8 * 16 * 4;
constexpr int DS_OW = DS_ML + 8 * 2 * 16 * 8;
constexpr int DS_END = DS_OW + 8 * 2 * 64 * 16 * 4;
constexpr int DS_BM = 0;
constexpr int DS_ML2 = 4352;
constexpr int DS_OW2 = DS_ML2 + 4 * 2 * 16 * 8;
static_assert(DS_END <= LDS_BYTES, "dsa LDS");

__device__ __forceinline__ unsigned sortable(float f) { const unsigned u = __float_as_uint(f); return (u & 0x80000000u) ? ~u : (u | 0x80000000u); }

__device__ __forceinline__ void dsa_item(const Params& p, unsigned char* smem, int grp, int b, int c, int sub) {
    const int tid = otid(p.wave), lane = tid & 63, w = tid >> 6, l15 = lane & 15, lg = lane >> 4;
    const int nk = grp == 0 ? (c + 1) * 64 : TKS;
    const int ntiles = nk >> 4;
    const int ldv = grp == 0 ? TP : TKS;
    const bf16_t* kI = (const bf16_t*)(p.ws + (grp == 0 ? WS_KIP : WS_KIS)) + (size_t)b * ldv * 64;
    const bf16_t* kB = (const bf16_t*)(p.ws + (grp == 0 ? WS_KBP : WS_KBS)) + (size_t)b * ldv * 256;
    const bf16_t* vT = (const bf16_t*)(p.ws + (grp == 0 ? WS_VTP : WS_VTS)) + (size_t)b * 256 * ldv;
    const bf16_t* qI = (const bf16_t*)(p.ws + WS_QI); const bf16_t* qB = (const bf16_t*)(p.ws + WS_QB);
    const float* wI = (const float*)(p.ws + WS_WI);
    bf16_t* mix = (bf16_t*)(p.ws + WS_H);
    int* CNT = (int*)(smem + DS_CNT); float* ML = (float*)(smem + DS_ML); float* OW = (float*)(smem + DS_OW);
    const int qr = (grp == 0 ? b * TP + c * 64 : MP + b * TS) + sub * 16;
    const int nblk = nk >> 5;
    const int krow = 8 * (l15 >> 2) + (l15 & 3);
    const unsigned kIoff = (unsigned)(((w * 32 + krow) * 64 + lg * 8) * 2);
    const unsigned kBoff = (unsigned)(((w * 32 + krow) * 256 + lg * 8) * 2);
    const unsigned vToff = (unsigned)((l15 * ldv + w * 32 + lg * 8) * 2);
    unsigned msk[3] = {0u, 0u, 0u};
    {
        unsigned keys[72];
        {
            bf16x8 bq[8][2]; float wq[8];
#pragma unroll
            for (int h = 0; h < 8; ++h) {
#pragma unroll
                for (int kk = 0; kk < 2; ++kk) bq[h][kk] = ldgp<bf16x8>(qI + (size_t)(qr + l15) * 512 + h * 64 + kk * 32 + lg * 8);
                wq[h] = ldgp<float>(wI + (size_t)(qr + l15) * 8 + h);
            }
            bf16x8 ka[4][2];
#define KI_SLOT_OFF(i) ((unsigned)((i) >> 1) * (8u * 32u * 128u) + (unsigned)((i) & 1) * (4u * 128u))
#pragma unroll
            for (int i = 0; i < 3; ++i)
                if (w + 8 * (i >> 1) < nblk) { const unsigned ko = opaque(kIoff) + KI_SLOT_OFF(i); ka[i][0] = ldg32<bf16x8>(kI, ko); ka[i][1] = ldg32<bf16x8>(kI, ko + 64u); }
            __builtin_amdgcn_sched_barrier(0);
#pragma unroll
            for (int i = 0; i < 18; ++i) {
                if (w + 8 * (i >> 1) < nblk) {
                    if (i + 3 < 18 && (w + 8 * ((i + 3) >> 1) < nblk)) { const unsigned ko = opaque(kIoff) + KI_SLOT_OFF(i + 3); ka[(i + 3) & 3][0] = ldg32<bf16x8>(kI, ko); ka[(i + 3) & 3][1] = ldg32<bf16x8>(kI, ko + 64u); }
                    const bf16x8 a0 = ka[i & 3][0], a1 = ka[i & 3][1];
                    f32x4 sc = (f32x4){0.f, 0.f, 0.f, 0.f};
#pragma unroll
                    for (int h = 0; h < 8; ++h) {
                        f32x4 a = mfma16(a0, bq[h][0], (f32x4){0.f, 0.f, 0.f, 0.f});
                        a = mfma16(a1, bq[h][1], a);
#pragma unroll
                        for (int j = 0; j < 4; ++j) sc[j] += wq[h] * fmaxf(a[j], 0.f);
                    }
#pragma unroll
                    for (int j = 0; j < 4; ++j) keys[i * 4 + j] = sortable(sc[j]);
                } else {
#pragma unroll
                    for (int j = 0; j < 4; ++j) keys[i * 4 + j] = 0u;
                }
                __builtin_amdgcn_sched_barrier(0);
            }
#undef KI_SLOT_OFF
        }
        unsigned thr = 1u;
        if (nk > 256) {
            unsigned* SC = (unsigned*)smem;
            unsigned* THR = (unsigned*)(smem + 16 * 2113 * 4);
#pragma unroll
            for (int i = 0; i < 18; ++i)
                if (w + 8 * (i >> 1) < nblk) {
                    const int kidx = 32 * (w + 8 * (i >> 1)) + 8 * lg + 4 * (i & 1);
#pragma unroll
                    for (int j = 0; j < 4; ++j) SC[l15 * 2113 + kidx + j] = keys[i * 4 + j];
                }
            __syncthreads();
            const int nr = nk >> 6;
#pragma unroll
            for (int qq = 0; qq < 2; ++qq) {
                unsigned myk[33];
#pragma unroll
                for (int r = 0; r < 33; ++r) myk[r] = (r < nr) ? SC[(2 * w + qq) * 2113 + r * 64 + lane] : 0u;
                unsigned t = 0u; int cat = nk;
                for (int bit = 31; bit >= 0; --bit) {
                    const unsigned cand = t | (1u << bit);
                    int cnt = 0;
#pragma unroll
                    for (int r = 0; r < 33; ++r) cnt += (int)__popcll(__ballot(myk[r] >= cand));
                    if (cnt >= 256) { t = cand; cat = cnt; }
                    if (cat == 256) break;
                }
                if (lane == 0) THR[2 * w + qq] = t;
            }
            __syncthreads();
            thr = THR[l15];
        }
#pragma unroll
        for (int i = 0; i < 72; ++i) msk[i >> 5] |= (keys[i] >= thr) ? (1u << (i & 31)) : 0u;
    }
    {
        unsigned char* BM = smem + DS_BM;
#pragma unroll
        for (int ip = 0; ip < 9; ++ip)
            if (w + 8 * ip < nblk) BM[(l15 * 66 + (w + 8 * ip)) * 4 + lg] = (unsigned char)((msk[(8 * ip) >> 5] >> ((8 * ip) & 31)) & 0xffu);
    }
    __syncthreads();
    {
        const int wu = __builtin_amdgcn_readfirstlane(w), n = wu >> 1, half = wu & 1;
        const unsigned char* BM = smem + DS_BM + l15 * 66 * 4 + lg;
        bf16x8 bqB[2][2];
#pragma unroll
        for (int g = 0; g < 2; ++g)
#pragma unroll
            for (int kk = 0; kk < 2; ++kk) bqB[g][kk] = ldgp<bf16x8>(qB + (size_t)(qr + l15) * 512 + (n * 2 + g) * 64 + kk * 32 + lg * 8);
        const unsigned kBc = (unsigned)((krow * 256 + lg * 8) * 2 + n * 128);
        const unsigned vTc = (unsigned)(((n * 64 + l15) * ldv + lg * 8) * 2);
        float mrun[2] = {-1e30f, -1e30f}, lrun[2] = {0.f, 0.f};
        f32x4 O[2][4];
#pragma unroll
        for (int g = 0; g < 2; ++g)
#pragma unroll
            for (int dt = 0; dt < 4; ++dt) O[g][dt] = (f32x4){0.f, 0.f, 0.f, 0.f};
        bf16x8 kf[2][2][2];
        bf16x8 vfb[2][4];
#define DSA_LOAD_BLK(BK, BUF) do { \
            const unsigned _ko = opaque(kBc) + (unsigned)(BK) * (32u * 512u); \
            kf[BUF][0][0] = ldg32<bf16x8>(kB, _ko); kf[BUF][0][1] = ldg32<bf16x8>(kB, _ko + 64u); \
            kf[BUF][1][0] = ldg32<bf16x8>(kB, _ko + 2048u); kf[BUF][1][1] = ldg32<bf16x8>(kB, _ko + 2048u + 64u); \
            _Pragma("unroll") for (int dt = 0; dt < 4; ++dt) vfb[BUF][dt] = ldg32<bf16x8>(vT, opaque(vTc) + (unsigned)(dt * 16 * ldv * 2) + (unsigned)(BK) * 64u); \
        } while (0)
#define DSA_PROCESS(BK, BUF) do { \
            f32x4 lgt[2][2]; \
            _Pragma("unroll") for (int e = 0; e < 2; ++e) _Pragma("unroll") for (int g = 0; g < 2; ++g) { \
                f32x4 a = mfma16(kf[BUF][e][0], bqB[g][0], (f32x4){0.f, 0.f, 0.f, 0.f}); lgt[g][e] = mfma16(kf[BUF][e][1], bqB[g][1], a); } \
            const unsigned sb = BM[(BK) * 4]; \
            _Pragma("unroll") for (int g = 0; g < 2; ++g) { \
                float tmax = -1e30f; \
                _Pragma("unroll") for (int e = 0; e < 2; ++e) _Pragma("unroll") for (int j = 0; j < 4; ++j) tmax = ((sb >> (4 * e + j)) & 1u) ? fmaxf(tmax, lgt[g][e][j]) : tmax; \
                tmax = fmaxf(tmax, __shfl_xor(tmax, 16)); tmax = fmaxf(tmax, __shfl_xor(tmax, 32)); \
                const float mnew = fmaxf(mrun[g], tmax); \
                const float alpha = __builtin_amdgcn_exp2f(mrun[g] - mnew); \
                mrun[g] = mnew; \
                float pv[2][4]; float psum = 0.f; \
                _Pragma("unroll") for (int e = 0; e < 2; ++e) _Pragma("unroll") for (int j = 0; j < 4; ++j) { \
                    pv[e][j] = ((sb >> (4 * e + j)) & 1u) ? __builtin_amdgcn_exp2f(lgt[g][e][j] - mnew) : 0.f; psum += pv[e][j]; } \
                lrun[g] = lrun[g] * alpha + psum; \
                const u32x4 pp = {pk2(pv[0][0], pv[0][1]), pk2(pv[0][2], pv[0][3]), pk2(pv[1][0], pv[1][1]), pk2(pv[1][2], pv[1][3])}; \
                const bf16x8 pf = __builtin_bit_cast(bf16x8, pp); \
                if (!__all(alpha == 1.f)) { _Pragma("unroll") for (int dt = 0; dt < 4; ++dt) O[g][dt] *= alpha; } \
                _Pragma("unroll") for (int dt = 0; dt < 4; ++dt) O[g][dt] = mfma16(vfb[BUF][dt], pf, O[g][dt]); \
            } \
        } while (0)
        const int cnt = (nblk - half + 1) >> 1;
        int Bk = half;
        if (cnt > 0) DSA_LOAD_BLK(Bk, 0);
        for (int it = 0; it < cnt; it += 2) {
            if (it + 1 < cnt) DSA_LOAD_BLK(Bk + 2, 1);
            DSA_PROCESS(Bk, 0);
            if (it + 1 < cnt) {
                if (it + 2 < cnt) DSA_LOAD_BLK(Bk + 4, 0);
                DSA_PROCESS(Bk + 2, 1);
            }
            Bk += 4;
        }
#undef DSA_LOAD_BLK
#undef DSA_PROCESS
        float* ML2 = (float*)(smem + DS_ML2); float* OW2 = (float*)(smem + DS_OW2);
#pragma unroll
        for (int g = 0; g < 2; ++g) { float l = lrun[g]; l += __shfl_xor(l, 16); l += __shfl_xor(l, 32); lrun[g] = l; }
        if (half == 1) {
#pragma unroll
            for (int g = 0; g < 2; ++g) {
                if (lane < 16) { ML2[((n * 2 + g) * 16 + lane) * 2] = mrun[g]; ML2[((n * 2 + g) * 16 + lane) * 2 + 1] = lrun[g]; }
#pragma unroll
                for (int dt = 0; dt < 4; ++dt)
#pragma unroll
                    for (int j = 0; j < 4; ++j) OW2[((n * 2 + g) * 64 + dt * 16 + lg * 4 + j) * 16 + l15] = O[g][dt][j];
            }
        }
        __syncthreads();
        if (half == 0) {
#pragma unroll
            for (int g = 0; g < 2; ++g) {
                const float m2 = ML2[((n * 2 + g) * 16 + l15) * 2], l2 = ML2[((n * 2 + g) * 16 + l15) * 2 + 1];
                const float M = fmaxf(mrun[g], m2);
                const float f1 = __builtin_amdgcn_exp2f(mrun[g] - M), f2 = __builtin_amdgcn_exp2f(m2 - M);
                const float inv = 1.f / (lrun[g] * f1 + l2 * f2);
#pragma unroll
                for (int dt = 0; dt < 4; ++dt) {
                    float o[4];
#pragma unroll
                    for (int j = 0; j < 4; ++j) o[j] = (O[g][dt][j] * f1 + OW2[((n * 2 + g) * 64 + dt * 16 + lg * 4 + j) * 16 + l15] * f2) * inv;
                    const u32x2 ov = {pk2(o[0], o[1]), pk2(o[2], o[3])};
                    stgp<u32x2>(mix + (size_t)(qr + l15) * D + 512 + (n * 2 + g) * 64 + dt * 16 + lg * 4, ov);
                }
            }
        }
    }
}

constexpr int MIX_ITEMS = 64 + 33 * 32;
__device__ __forceinline__ void mixer_phase(const Params& p, unsigned char* smem) {
    int* counter = (int*)(p.ws + WS_QUEUE);
    volatile int* slot = (volatile int*)(smem + LDS_BYTES - 16);
    for (;;) {
        if (threadIdx.x == 0) *slot = atomicAdd(counter, 1);
        __syncthreads();
        const int item = *slot;
        __syncthreads();
        if (item >= MIX_ITEMS) break;
        if (item < 64) {
            hgrn_unit(p, smem, item >> 5, (item & 31) >> 2, item & 3);
        } else {
            const int j = item - 64, rank = j >> 5, bs = j & 31;
            dsa_item(p, smem, rank == 0 ? 1 : 0, bs >> 2, 32 - rank, bs & 3);
        }
        __syncthreads();
    }
}

#define XB_TMO      128
#define XB_XCNT(j)  (256  + 64 * (j))
#define XB_XSUB(j)  (1280 + 64 * (j))
#define XB_XGEN(j)  (2304 + 64 * (j))
#define XB_TOP      3328
#define XB_TOPGEN   3392
#define XCD_BAR_WORDS 3456
#define XB_SPIN_CAP (1u << 18)
__device__ __forceinline__ unsigned xb_ld(unsigned* p)              { return __hip_atomic_load(p, __ATOMIC_RELAXED, __HIP_MEMORY_SCOPE_AGENT); }
__device__ __forceinline__ unsigned xb_add(unsigned* p, unsigned v) { return __hip_atomic_fetch_add(p, v, __ATOMIC_RELAXED, __HIP_MEMORY_SCOPE_AGENT); }
__device__ __forceinline__ unsigned xb_xcc_id() { return (unsigned)__builtin_amdgcn_s_getreg((3 << 11) | 20) & 0xFu; }
#define XB_SPIN(cond, bar) do { unsigned _sp = 0; while (cond) { __builtin_amdgcn_s_sleep(1); \
    if ((++_sp & 255u) == 0u) { if (xb_ld(&(bar)[XB_TMO])) break; if (_sp > XB_SPIN_CAP) { atomicAdd(&(bar)[XB_TMO], 1u); break; } } } } while (0)
struct XcdBarrier { unsigned* bar; unsigned x; volatile LAS unsigned* st; };
__device__ __forceinline__ XcdBarrier xcd_barrier_post(unsigned* bar, volatile LAS unsigned* st) {
    XcdBarrier b; b.bar = bar; b.x = xb_xcc_id(); b.st = st;
    if (threadIdx.x == 0) (void)xb_add(&bar[XB_XCNT(b.x)], 1u);
    return b;
}
__device__ __forceinline__ void xcd_barrier_complete(unsigned* bar, unsigned x, unsigned& nloc, unsigned& nx) {
    const unsigned G = gridDim.x * gridDim.y * gridDim.z;
    unsigned sum, cnt, mine, sp = 0u;
    for (;;) {
        sum = 0u; cnt = 0u; mine = 0u;
#pragma unroll
        for (unsigned j = 0; j < 16; ++j) { const unsigned c = xb_ld(&bar[XB_XCNT(j)]); sum += c; cnt += (c > 0u) ? 1u : 0u; mine = (j == x) ? c : mine; }
        if (sum == G) break;
        __builtin_amdgcn_s_sleep(1);
        if ((++sp & 255u) == 0u) { if (xb_ld(&bar[XB_TMO])) break; if (sp > XB_SPIN_CAP) { atomicAdd(&bar[XB_TMO], 1u); break; } }
    }
    nloc = mine > 0u ? mine : 1u; nx = cnt > 0u ? cnt : 1u;
}
__device__ __forceinline__ void xcd_barrier(const XcdBarrier& b) {
    asm volatile("s_waitcnt vmcnt(0)" ::: "memory");
    __syncthreads();
    if (threadIdx.x == 0) {
        unsigned* bar = b.bar;
        __builtin_amdgcn_s_waitcnt(0);
        unsigned nloc = b.st[0], nx = b.st[1];
        if (nloc == 0u) { xcd_barrier_complete(bar, b.x, nloc, nx); b.st[0] = nloc; b.st[1] = nx; }
        const unsigned old = xb_add(&bar[XB_XSUB(b.x)], 1u);
        const unsigned gen = old / nloc;
        if (old + 1u == (gen + 1u) * nloc) {
            __builtin_amdgcn_fence(__ATOMIC_RELEASE, "agent");
            asm volatile("s_waitcnt vmcnt(0)" ::: "memory");
            const unsigned og = xb_add(&bar[XB_TOP], 1u);
            const unsigned tg = og / nx;
            if (og + 1u == (tg + 1u) * nx) xb_add(&bar[XB_TOPGEN], 1u);
            else XB_SPIN(xb_ld(&bar[XB_TOPGEN]) == tg, bar);
            __builtin_amdgcn_fence(__ATOMIC_ACQUIRE, "agent");
            xb_add(&bar[XB_XGEN(b.x)], 1u);
            asm volatile("s_waitcnt vmcnt(0)" ::: "memory");
        } else {
            XB_SPIN(xb_ld(&bar[XB_XGEN(b.x)]) == gen, bar);
            __builtin_amdgcn_fence(__ATOMIC_ACQUIRE, "agent");
            asm volatile("s_waitcnt vmcnt(0)" ::: "memory");
        }
    }
    __syncthreads();
}

#ifndef ONE_LAUNCH
#define ONE_LAUNCH 1
#endif
template <int PH> __global__ void __launch_bounds__(NTHREADS) fwd_kernel(Params p) {
    extern __shared__ __attribute__((aligned(16))) unsigned char smem[];
    LAS unsigned char* lds = (LAS unsigned char*)smem;
    const int G = (int)gridDim.x, cb = (int)blockIdx.x;
    const int wave_id = __builtin_amdgcn_readfirstlane((int)threadIdx.x >> 6);
    constexpr bool MULTI = (PH & (PH - 1)) != 0;
    volatile LAS unsigned* xst = (volatile LAS unsigned*)(lds + LDS_BYTES - 32);
    if constexpr (MULTI) { if (threadIdx.x == 0) { xst[0] = 0u; xst[1] = 0u; } __syncthreads(); }
    XcdBarrier xb{};
    if constexpr (MULTI) xb = xcd_barrier_post((unsigned*)(p.ws + WS_BAR), xst);
#define GRID_SYNC() do { if constexpr (MULTI) xcd_barrier(xb); } while (0)
#define FRESH(q) Params q = p; q.wave = wave_id; asm volatile("" : "+s"(q.ws), "+s"(q.out))
    if constexpr (PH & 1) { FRESH(q); phase0(q, (float*)smem); }
    GRID_SYNC();
    if constexpr (PH & 2) { FRESH(q); norm_phase<0>(q); }
    GRID_SYNC();
    if constexpr (PH & 4) {
        FRESH(q);
        pg8::Gemm g{(const bf16_t*)(q.ws + WS_H), (const bf16_t*)(q.ws + WS_WTIN), MT, NINP, D, q.wave};
        pg8::StaticOrder S; S.init(MT, NINP, D, G, cb, 1);
        EpiIn E{q.out, q.ws, (const float*)(q.ws + WS_LB)};
        pg8::gemm_phase(lds, g, S, E);
    }
    GRID_SYNC();
    if constexpr (PH & 8) { FRESH(q); mixer_phase(q, smem); }
    GRID_SYNC();
    if constexpr (PH & 16) {
        FRESH(q);
        pg8::Gemm g{(const bf16_t*)(q.ws + WS_H), (const bf16_t*)(q.ws + WS_WTOUT), MT, D, D, q.wave};
        pg8::StaticOrder S; S.init(MT, D, D, G, cb, q.ksplit);
        EpiRes<0> E{q.in[0], q.in[1], q.out + OFF_Y, (const float*)(q.ws + WS_MOD), (float*)(q.ws + WS_R)};
        pg8::gemm_phase(lds, g, S, E);
    }
    GRID_SYNC();
    if constexpr (PH & 32) { FRESH(q); norm_phase<1>(q); }
    GRID_SYNC();
    if constexpr (PH & 64) {
        FRESH(q);
        pg8::Gemm g{(const bf16_t*)(q.ws + WS_H), (const bf16_t*)(q.ws + WS_WTF1), MT, DFF, D, q.wave};
        pg8::StaticOrder S; S.init(MT, DFF, D, G, cb, 1);
        EpiFF1 E{(bf16_t*)(q.ws + WS_U)};
        pg8::gemm_phase(lds, g, S, E);
    }
    GRID_SYNC();
    if constexpr (PH & 128) {
        FRESH(q);
        pg8::Gemm g{(const bf16_t*)(q.ws + WS_U), (const bf16_t*)(q.ws + WS_WTF2), MT, D, DFF, q.wave};
        pg8::StaticOrder S; S.init(MT, D, DFF, G, cb, q.ksplit > 1 ? 16 : 1);
        EpiRes<1> E{nullptr, nullptr, q.out + OFF_Y, (const float*)(q.ws + WS_MOD), (float*)(q.ws + WS_H)};
        pg8::gemm_phase(lds, g, S, E);
    }
    GRID_SYNC();
    if constexpr (PH & 256) { FRESH(q); norm_phase<2>(q); }
#undef FRESH
#undef GRID_SYNC
}

template <int PH> static bool prep_kernel() {
    return hipFuncSetAttribute((const void*)fwd_kernel<PH>, hipFuncAttributeMaxDynamicSharedMemorySize, LDS_BYTES) == hipSuccess;
}
template <int PH> static void launch_plain(const Params& p, int grid, hipStream_t stream) {
    hipLaunchKernelGGL(fwd_kernel<PH>, dim3(grid), dim3(NTHREADS), LDS_BYTES, stream, p);
}

extern "C" void kernel_launch(void* const* d_in, const int* in_sizes, int n_in, void* d_out, int out_size, void* d_ws, size_t ws_size, hipStream_t stream) {
    static int grid_blocks = 0;
    if (grid_blocks == 0) {
        if (n_in != 19 || ws_size < WS_END) { fprintf(stderr, "kernel_launch: unexpected n_in %d / ws_size %zu (need %zu)\n", n_in, ws_size, (size_t)WS_END); grid_blocks = -1; return; }
        int dev = 0, cus = 0, per_cu = 0;
        (void)hipGetDevice(&dev);
        (void)hipDeviceGetAttribute(&cus, hipDeviceAttributeMultiprocessorCount, dev);
#if ONE_LAUNCH
        if (!prep_kernel<511>()) { fprintf(stderr, "kernel_launch: hipFuncSetAttribute failed\n"); grid_blocks = -1; return; }
        if (hipOccupancyMaxActiveBlocksPerMultiprocessor(&per_cu, (const void*)fwd_kernel<511>, NTHREADS, LDS_BYTES) != hipSuccess || per_cu < 1) { fprintf(stderr, "kernel_launch: occupancy query failed (%d)\n", per_cu); grid_blocks = -1; return; }
        grid_blocks = cus * per_cu;
#else
        bool ok = prep_kernel<1>() && prep_kernel<2>() && prep_kernel<4>() && prep_kernel<8>() && prep_kernel<16>() && prep_kernel<32>() && prep_kernel<64>() && prep_kernel<128>() && prep_kernel<256>();
        if (!ok) { fprintf(stderr, "kernel_launch: hipFuncSetAttribute failed\n"); grid_blocks = -1; return; }
        (void)per_cu;
        grid_blocks = cus;
#endif
    }
    if (grid_blocks < 0) return;
    Params p{};
    for (int i = 0; i < 19; ++i) p.in[i] = (const float*)d_in[i];
    p.out = (float*)d_out; p.ws = (unsigned char*)d_ws;
    {
        const int nM = MT / 256, nN = 4, nwg = nM * nN, G = grid_blocks, nfull = (nwg / G) * G, ntail = nwg - nfull;
        p.ntail = 0; p.ksplit = 1;
        if (ntail > 0 && ntail <= 8) {
            p.ntail = ntail; p.ksplit = 4;
            for (int t = 0; t < ntail; ++t) {
                int wgid = nfull + t;
                { const int q = nwg / 8, r = nwg % 8, xcd = wgid % 8, off = wgid / 8; wgid = (xcd < r ? xcd * (q + 1) : r * (q + 1) + (xcd - r) * q) + off; }
                const int nig = 8 * nN, gid = wgid / nig, fm = gid * 8, gsz = (nM - fm) < 8 ? (nM - fm) : 8;
                const int pm = fm + ((wgid % nig) % gsz), pn = (wgid % nig) / gsz;
                p.tail[t] = pm * 4 + pn;
            }
        }
    }
#if ONE_LAUNCH
    (void)hipMemsetAsync((unsigned char*)d_ws + WS_QUEUE, 0, 256 + 16384, stream);
    void* args[] = {&p};
    hipError_t e = hipLaunchCooperativeKernel((const void*)fwd_kernel<511>, dim3(grid_blocks), dim3(NTHREADS), args, LDS_BYTES, stream);
    if (e != hipSuccess) fprintf(stderr, "cooperative launch failed: %s (grid %d)\n", hipGetErrorString(e), grid_blocks);
#else
    launch_plain<1>(p, grid_blocks, stream);
    launch_plain<2>(p, grid_blocks, stream);
    launch_plain<4>(p, grid_blocks, stream);
    launch_plain<8>(p, grid_blocks, stream);
    launch_plain<16>(p, grid_blocks, stream);
    launch_plain<32>(p, grid_blocks, stream);
    launch_plain<64>(p, grid_blocks, stream);
    launch_plain<128>(p, grid_blocks, stream);
    launch_plain<256>(p, grid_blocks, stream);
#endif
}
```
